# Optimizing an MI355X kernel written in HIP

```python
import jax
import jax.numpy as jnp
from jax import lax
import numpy as np

D_MODEL = 1024
BATCH = 4
SEQ = 4096
DEPTH = 4

HEAD_DIM = 64
N_HEADS = D_MODEL // HEAD_DIM
D_MIX = N_HEADS * HEAD_DIM
GLA_HEADS = N_HEADS // 4
NSA_HEADS = N_HEADS // 2
NSA_KV_HEADS = NSA_HEADS // 4
RET_HEADS = N_HEADS - GLA_HEADS - NSA_HEADS
GLA_W = GLA_HEADS * HEAD_DIM
NSA_W = NSA_HEADS * HEAD_DIM
NSA_KV_W = NSA_KV_HEADS * HEAD_DIM
RET_W = RET_HEADS * HEAD_DIM
GLA_LOWRANK = 16
GLA_TAU = 16.0
CHUNK = 64
CMP_LEN = 32
CMP_STRIDE = 16
CMP_HIDDEN = 128
SLC_LEN = 64
SLC_TOPK = 16
WINDOW = 512
Q_BLOCK = 128
ROPE_THETA = 10000.0
D_FF = 2816
FFN_HALF = 0.5
NORM_EPS = 1e-6
NEG_INF = -1e30
FORCED_SCORE = 1e4
N_ADA = 9

IN_SIZES = (GLA_W, GLA_W, GLA_W, GLA_W, GLA_LOWRANK,
            NSA_W, NSA_KV_W, NSA_KV_W, NSA_KV_W, NSA_KV_W, NSA_KV_W, NSA_KV_W, 3 * NSA_HEADS,
            RET_W, RET_W, RET_W, RET_W)
IN_W = sum(IN_SIZES)
IN_SPLITS = tuple(int(s) for s in np.cumsum(IN_SIZES)[:-1])

kernel_name = 'hybrid_gla_nsa_retnet_macaron_adaln'


def rms_norm(x, g):
    xf = x.astype(jnp.float32)
    y = xf * lax.rsqrt(jnp.mean(xf * xf, axis=-1, keepdims=True) + NORM_EPS) * g
    return y.astype(x.dtype)


def group_norm(x, g):
    xf = x.astype(jnp.float32)
    xc = xf - jnp.mean(xf, axis=-1, keepdims=True)
    return xc * lax.rsqrt(jnp.mean(xc * xc, axis=-1, keepdims=True) + NORM_EPS) * g


def rotary(x, pos):
    half = x.shape[-1] // 2
    inv_freq = ROPE_THETA ** (-jnp.arange(half, dtype=jnp.float32) / half)
    ang = pos.astype(jnp.float32)[:, None] * inv_freq[None, :]
    cos, sin = jnp.cos(ang), jnp.sin(ang)
    xf = x.astype(jnp.float32)
    x1, x2 = xf[..., :half], xf[..., half:]
    return jnp.concatenate([x1 * cos - x2 * sin, x1 * sin + x2 * cos], axis=-1)


def modulate(h, shift, scale):
    return h * (1.0 + scale[:, None, :]) + shift[:, None, :]


def swiglu(h, w_in, w_out):
    gate, up = jnp.split(h @ w_in, 2, axis=-1)
    return (jax.nn.silu(gate) * up) @ w_out


def gla_chunked(q, k, v, log_a):
    B, H, T, dk = q.shape
    dv = v.shape[-1]
    n = T // CHUNK
    f32 = jnp.float32
    q = (q.astype(f32) * dk ** -0.5).reshape(B, H, n, CHUNK, dk)
    k = k.astype(f32).reshape(B, H, n, CHUNK, dk)
    v = v.astype(f32).reshape(B, H, n, CHUNK, dv)
    b = jnp.cumsum(log_a.astype(f32).reshape(B, H, n, CHUNK, dk), axis=3)
    b_last = b[:, :, :, -1:, :]
    q_dec = q * jnp.exp(b)
    causal = jnp.tril(jnp.ones((CHUNK, CHUNK), dtype=bool))
    attn = jnp.einsum('bhnid,bhnjd->bhnij', q_dec, k * jnp.exp(-b))
    attn = jnp.where(causal, attn, 0.0)
    o_intra = jnp.einsum('bhnij,bhnjv->bhniv', attn, v)
    kv = jnp.einsum('bhnjd,bhnjv->bhndv', k * jnp.exp(b_last - b), v)
    chunk_decay = jnp.exp(b_last[:, :, :, 0, :])

    def step(state, inp):
        kv_n, dec_n = inp
        return state * dec_n[..., None] + kv_n, state

    _, s_prev = lax.scan(step, jnp.zeros((B, H, dk, dv), f32),
                         (jnp.moveaxis(kv, 2, 0), jnp.moveaxis(chunk_decay, 2, 0)))
    o_inter = jnp.einsum('bhnid,bhndv->bhniv', q_dec, jnp.moveaxis(s_prev, 0, 2))
    return (o_intra + o_inter).reshape(B, H, T, dv)


def retention_chunked(q, k, v, log_gamma):
    B, H, T, dk = q.shape
    dv = v.shape[-1]
    n = T // CHUNK
    f32 = jnp.float32
    q = q.astype(f32).reshape(B, H, n, CHUNK, dk)
    k = (k.astype(f32) * dk ** -0.5).reshape(B, H, n, CHUNK, dk)
    v = v.astype(f32).reshape(B, H, n, CHUNK, dv)
    idx = jnp.arange(CHUNK, dtype=f32)
    rel = idx[:, None] - idx[None, :]
    decay = jnp.where(rel >= 0, jnp.exp(log_gamma[:, None, None] * rel), 0.0)
    attn = jnp.einsum('bhnid,bhnjd->bhnij', q, k) * decay[None, :, None]
    o_intra = jnp.einsum('bhnij,bhnjv->bhniv', attn, v)
    q_dec = q * jnp.exp(log_gamma[:, None] * (idx + 1.0))[None, :, None, :, None]
    k_dec = k * jnp.exp(log_gamma[:, None] * (CHUNK - 1.0 - idx))[None, :, None, :, None]
    kv = jnp.einsum('bhnjd,bhnjv->bhndv', k_dec, v)
    chunk_decay = jnp.exp(log_gamma * CHUNK)[None, :, None, None]

    def step(state, kv_n):
        return state * chunk_decay + kv_n, state

    _, s_prev = lax.scan(step, jnp.zeros((B, H, dk, dv), f32), jnp.moveaxis(kv, 2, 0))
    o_inter = jnp.einsum('bhnid,bhndv->bhniv', q_dec, jnp.moveaxis(s_prev, 0, 2))
    return (o_intra + o_inter).reshape(B, H, T, dv)


def compress_blocks(blocks, pe, w1, w2):
    h = (blocks + pe).reshape(blocks.shape[:-2] + (CMP_LEN * blocks.shape[-1],))
    return jax.nn.silu(h @ w1) @ w2


def nsa_attention(q, k_cmp, v_cmp, k_slc, v_slc, k_win, v_win, gate_logits,
                  pe_k, pe_v, w1_k, w2_k, w1_v, w2_v, pos):
    f32 = jnp.float32
    B, H, T, dh = q.shape
    G = k_cmp.shape[1]
    R = H // G
    scale = dh ** -0.5
    t = jnp.arange(T)
    q_raw = q.astype(f32).reshape(B, G, R, T, dh) * scale
    q_rot = rotary(q, pos).reshape(B, G, R, T, dh) * scale
    k_cmp, v_cmp, v_slc, v_win = (a.astype(f32) for a in (k_cmp, v_cmp, v_slc, v_win))
    k_slc_r = rotary(k_slc, pos)
    k_win_r = rotary(k_win, pos)

    n_cmp = (T - CMP_LEN) // CMP_STRIDE + 1
    c_start = np.arange(n_cmp) * CMP_STRIDE
    c_idx = c_start[:, None] + np.arange(CMP_LEN)[None, :]
    k_c = compress_blocks(k_cmp[:, :, c_idx], pe_k, w1_k, w2_k)
    v_c = compress_blocks(v_cmp[:, :, c_idx], pe_v, w1_v, w2_v)
    s_c = jnp.einsum('bgrtd,bgnd->bgrtn', q_raw, k_c)
    valid_c = (c_start + CMP_LEN - 1)[None, :] <= t[:, None]
    p_c = jax.nn.softmax(jnp.where(valid_c, s_c, NEG_INF), axis=-1) * valid_c
    o_cmp = jnp.einsum('bgrtn,bgnd->bgrtd', p_c, v_c)

    n_slc = T // SLC_LEN
    s_start = np.arange(n_slc) * SLC_LEN
    overlap = ((c_start[:, None] < s_start[None, :] + SLC_LEN)
               & (c_start[:, None] + CMP_LEN > s_start[None, :])).astype(np.float32)
    imp = jnp.einsum('bgrtn,ns->bgts', p_c, jnp.asarray(overlap))
    cur = t // SLC_LEN
    blk = jnp.arange(n_slc)
    forced = (blk[None, :] == 0) | (blk[None, :] == cur[:, None]) | (blk[None, :] == cur[:, None] - 1)
    causal_s = blk[None, :] <= cur[:, None]
    imp = jnp.where(forced, FORCED_SCORE, jnp.where(causal_s, imp, -1.0))
    n_sel = min(SLC_TOPK, n_slc)
    _, sel = lax.top_k(imp, n_sel)

    k_sb = k_slc_r.reshape(B, G, n_slc, SLC_LEN, dh)
    v_sb = v_slc.reshape(B, G, n_slc, SLC_LEN, dh)
    nqb = T // Q_BLOCK
    b_ix = jnp.arange(B)[:, None, None, None]
    g_ix = jnp.arange(G)[None, :, None, None]

    def select_block(args):
        qb, selb, tb = args
        kg = k_sb[b_ix, g_ix, selb]
        vg = v_sb[b_ix, g_ix, selb]
        s = jnp.einsum('bgrqd,bgqkld->bgrqkl', qb, kg)
        kpos = selb[..., None] * SLC_LEN + jnp.arange(SLC_LEN)
        ok = (kpos <= tb[:, None, None])[:, :, None]
        s = jnp.where(ok, s, NEG_INF).reshape(B, G, R, Q_BLOCK, n_sel * SLC_LEN)
        p = jax.nn.softmax(s, axis=-1).reshape(B, G, R, Q_BLOCK, n_sel, SLC_LEN)
        return jnp.einsum('bgrqkl,bgqkld->bgrqd', p, vg)

    q_blocks = jnp.moveaxis(q_rot.reshape(B, G, R, nqb, Q_BLOCK, dh), 3, 0)
    sel_blocks = jnp.moveaxis(sel.reshape(B, G, nqb, Q_BLOCK, n_sel), 2, 0)
    o_slc = lax.map(select_block, (q_blocks, sel_blocks, t.reshape(nqb, Q_BLOCK)))
    o_slc = jnp.moveaxis(o_slc, 0, 3).reshape(B, G, R, T, dh)

    n_band = WINDOW // Q_BLOCK + 1

    def band(a):
        ap = jnp.pad(a, ((0, 0), (0, 0), (WINDOW, 0), (0, 0))).reshape(B, G, nqb + n_band - 1, Q_BLOCK, dh)
        return jnp.concatenate([ap[:, :, i:i + nqb] for i in range(n_band)], axis=3)

    k_w, v_w = band(k_win_r), band(v_win)
    s_w = jnp.einsum('bgrnid,bgnjd->bgrnij', q_rot.reshape(B, G, R, nqb, Q_BLOCK, dh), k_w)
    qpos = t.reshape(nqb, Q_BLOCK)[:, :, None]
    kpos = ((jnp.arange(nqb)[:, None] - (n_band - 1)) * Q_BLOCK + jnp.arange(n_band * Q_BLOCK)[None, :])[:, None, :]
    ok_w = (kpos <= qpos) & (kpos > qpos - WINDOW) & (kpos >= 0)
    p_w = jax.nn.softmax(jnp.where(ok_w, s_w, NEG_INF), axis=-1)
    o_win = jnp.einsum('bgrnij,bgnjd->bgrnid', p_w, v_w).reshape(B, G, R, T, dh)

    gate = jax.nn.sigmoid(gate_logits.astype(f32)).reshape(B, T, H, 3)
    gate = gate.transpose(0, 2, 1, 3).reshape(B, G, R, T, 3)
    o = gate[..., 0:1] * o_cmp + gate[..., 1:2] * o_slc + gate[..., 2:3] * o_win
    return o.reshape(B, H, T, dh)


def token_mixer(h, w_in, gla_a2, gla_a_bias, gla_norm_g, nsa_pe_k, nsa_pe_v, nsa_w1_k, nsa_w2_k,
                nsa_w1_v, nsa_w2_v, nsa_gate_bias, ret_norm_g, w_out):
    B, T, _ = h.shape
    pos = jnp.arange(T)

    def heads(a, n):
        return a.reshape(B, T, n, HEAD_DIM).transpose(0, 2, 1, 3)

    def merge(a):
        return a.transpose(0, 2, 1, 3).reshape(B, T, -1).astype(h.dtype)

    proj = h @ w_in
    (g_q, g_k, g_v, g_g, g_lr,
     n_q, n_kc, n_vc, n_ks, n_vs, n_kw, n_vw, n_gate,
     r_q, r_k, r_v, r_g) = jnp.split(proj, IN_SPLITS, axis=-1)

    log_a = jax.nn.log_sigmoid((g_lr @ gla_a2 + gla_a_bias).astype(jnp.float32)) / GLA_TAU
    o_gla = gla_chunked(heads(g_q, GLA_HEADS), heads(g_k, GLA_HEADS), heads(g_v, GLA_HEADS),
                        heads(log_a, GLA_HEADS))
    o_gla = merge(rms_norm(o_gla, gla_norm_g)) * jax.nn.silu(g_g)

    o_nsa = nsa_attention(heads(n_q, NSA_HEADS), heads(n_kc, NSA_KV_HEADS), heads(n_vc, NSA_KV_HEADS),
                          heads(n_ks, NSA_KV_HEADS), heads(n_vs, NSA_KV_HEADS),
                          heads(n_kw, NSA_KV_HEADS), heads(n_vw, NSA_KV_HEADS),
                          n_gate + nsa_gate_bias, nsa_pe_k, nsa_pe_v, nsa_w1_k, nsa_w2_k,
                          nsa_w1_v, nsa_w2_v, pos)
    o_nsa = merge(o_nsa)

    log_gamma = jnp.log1p(-jnp.exp2(-5.0 - jnp.arange(RET_HEADS, dtype=jnp.float32)))
    o_ret = retention_chunked(rotary(heads(r_q, RET_HEADS), pos), rotary(heads(r_k, RET_HEADS), pos),
                              heads(r_v, RET_HEADS), log_gamma)
    o_ret = merge(group_norm(o_ret, ret_norm_g)) * jax.nn.silu(r_g)

    return jnp.concatenate([o_gla, o_nsa, o_ret], axis=-1) @ w_out


def setup_inputs(seed: int = 0) -> dict:
    key = jax.random.key(seed)
    ks = jax.random.split(key, 23)
    f32 = jnp.float32

    def nrm(k, shape, scale):
        return jax.random.normal(k, shape, f32) * scale

    L, D = DEPTH, D_MODEL
    cmp_in = CMP_LEN * HEAD_DIM
    return {
        'x': nrm(ks[0], (BATCH, SEQ, D), 1.0),
        'c': nrm(ks[1], (BATCH, D), 1.0),
        'w_ada': nrm(ks[2], (L, D, N_ADA * D), 0.5 * D ** -0.5),
        'b_ada': nrm(ks[3], (L, N_ADA * D), 0.02),
        'norm_g': 1.0 + nrm(ks[4], (L, 3, D), 0.05),
        'ffn1_in': nrm(ks[5], (L, D, 2 * D_FF), D ** -0.5),
        'ffn1_out': nrm(ks[6], (L, D_FF, D), D_FF ** -0.5),
        'w_in': nrm(ks[7], (L, D, IN_W), D ** -0.5),
        'gla_a2': nrm(ks[8], (L, GLA_LOWRANK, GLA_W), GLA_LOWRANK ** -0.5),
        'gla_a_bias': nrm(ks[9], (L, GLA_W), 0.1),
        'gla_norm_g': 1.0 + nrm(ks[10], (L, HEAD_DIM), 0.05),
        'nsa_pe_k': nrm(ks[11], (L, CMP_LEN, HEAD_DIM), 0.1),
        'nsa_pe_v': nrm(ks[12], (L, CMP_LEN, HEAD_DIM), 0.1),
        'nsa_w1_k': nrm(ks[13], (L, cmp_in, CMP_HIDDEN), cmp_in ** -0.5),
        'nsa_w2_k': nrm(ks[14], (L, CMP_HIDDEN, HEAD_DIM), CMP_HIDDEN ** -0.5),
        'nsa_w1_v': nrm(ks[15], (L, cmp_in, CMP_HIDDEN), cmp_in ** -0.5),
        'nsa_w2_v': nrm(ks[16], (L, CMP_HIDDEN, HEAD_DIM), CMP_HIDDEN ** -0.5),
        'nsa_gate_bias': nrm(ks[17], (L, 3 * NSA_HEADS), 0.1),
        'ret_norm_g': 1.0 + nrm(ks[18], (L, HEAD_DIM), 0.05),
        'w_out': nrm(ks[19], (L, D_MIX, D), D_MIX ** -0.5),
        'ffn2_in': nrm(ks[20], (L, D, 2 * D_FF), D ** -0.5),
        'ffn2_out': nrm(ks[21], (L, D_FF, D), D_FF ** -0.5),
        'final_norm_g': 1.0 + nrm(ks[22], (D,), 0.05),
    }


def reference(x, c, w_ada, b_ada, norm_g, ffn1_in, ffn1_out, w_in, gla_a2, gla_a_bias, gla_norm_g,
              nsa_pe_k, nsa_pe_v, nsa_w1_k, nsa_w2_k, nsa_w1_v, nsa_w2_v, nsa_gate_bias, ret_norm_g,
              w_out, ffn2_in, ffn2_out, final_norm_g):
    c_act = jax.nn.silu(c)
    for l in range(DEPTH):
        mod = c_act @ w_ada[l] + b_ada[l]
        sh1, sc1, gt1, shm, scm, gtm, sh2, sc2, gt2 = jnp.split(mod, N_ADA, axis=-1)
        h = modulate(rms_norm(x, norm_g[l, 0]), sh1, sc1)
        x = x + FFN_HALF * gt1[:, None, :] * swiglu(h, ffn1_in[l], ffn1_out[l])
        h = modulate(rms_norm(x, norm_g[l, 1]), shm, scm)
        x = x + gtm[:, None, :] * token_mixer(h, w_in[l], gla_a2[l], gla_a_bias[l], gla_norm_g[l],
                                              nsa_pe_k[l], nsa_pe_v[l], nsa_w1_k[l], nsa_w2_k[l],
                                              nsa_w1_v[l], nsa_w2_v[l], nsa_gate_bias[l],
                                              ret_norm_g[l], w_out[l])
        h = modulate(rms_norm(x, norm_g[l, 2]), sh2, sc2)
        x = x + FFN_HALF * gt2[:, None, :] * swiglu(h, ffn2_in[l], ffn2_out[l])
    return rms_norm(x, final_norm_g)
```

```cpp
#include <hip/hip_runtime.h>
#include <cstdio>
#include <cstdint>
namespace pg8 {
#define PG8_LAS __attribute__((address_space(3)))
typedef unsigned short bf16_t;
typedef short bf16x8 __attribute__((ext_vector_type(8)));
typedef float f32x4 __attribute__((ext_vector_type(4)));
typedef unsigned u32x4 __attribute__((ext_vector_type(4)));
constexpr int BM = 256, BK = 64, HALF = 128, HTB = HALF * BK * 2  , STAGE_BYTES = 8 * HTB, NXCD = 8, WGM = 8;

__host__ __device__ __forceinline__ int lds_byte(int r, int c) { const int st = (r >> 4) * 2 + (c >> 5), rr = r & 15, cc = c & 31, ob = rr * 64 + cc * 2; return st * 1024 + (ob ^ (((ob >> 9) & 1) << 5)); }
__host__ __device__ __forceinline__ void stage_rc(int b, int& R, int& C) { const int st = b / 1024, sb = b % 1024, swz = sb ^ (((sb >> 9) & 1) << 5); R = (st >> 1) * 16 + swz / 64; C = (st & 1) * 32 + (swz % 64) / 2; }
__host__ __device__ __forceinline__ int perm32(int rho) { const int n = rho >> 4, i = rho & 15; return 8 * (i >> 2) + 4 * n + (i & 3); }

struct Unit { int pm, pn; };
struct Gemm { const bf16_t* A; const bf16_t* Bt; int M, N, K; };

struct StaticOrder {
    int nM, nN, nwg, G, c;
    __host__ __device__ void init(int M, int N, int G_, int c_) { nM = M / BM; nN = N / BM; nwg = nM * nN; G = G_; c = c_; }
    __host__ __device__ bool next(int i, Unit& u) const {
        const long L = (long)i * G + c; if (L >= nwg) return false;
        int wgid = (int)L; { const int q = nwg / NXCD, r = nwg % NXCD, xcd = wgid % NXCD, off = wgid / NXCD; wgid = (xcd < r ? xcd * (q + 1) : r * (q + 1) + (xcd - r) * q) + off; }
        const int nig = WGM * nN, gid = wgid / nig, fm = gid * WGM, gsz = (nM - fm) < WGM ? (nM - fm) : WGM;
        u.pm = fm + ((wgid % nig) % gsz); u.pn = (wgid % nig) / gsz; return true;
    }
    __device__ __forceinline__ void a_ready(const Unit&) const {}
    __device__ __forceinline__ void done(const Unit&) const {}
};

__device__ __forceinline__ unsigned cvt_pk_bf16(float lo, float hi) { unsigned r; asm volatile("v_cvt_pk_bf16_f32 %0, %1, %2" : "=v"(r) : "v"(lo), "v"(hi)); return r; }
__device__ __forceinline__ float silu_f(float x) { return x * __builtin_amdgcn_rcpf(1.0f + __builtin_amdgcn_exp2f(-1.4426950408889634f * x)); }

struct EpiSwiglu {
    static constexpr bool PERM = true, AFTER_DRAIN = false;
    bf16_t* O; int ldc;
    __device__ __forceinline__ void operator()(const f32x4 (&acc)[2][2][4][2], const Unit& u, int wr, int wc, int fr, int fq) const {
        const int row0 = u.pm * BM + wr * 64 + fr; const int col0 = u.pn * HALF + wc * 32 + 8 * fq;
#pragma unroll
        for (int ai = 0; ai < 2; ++ai)
#pragma unroll
            for (int m = 0; m < 4; ++m) { bf16_t* rowp = O + (size_t)(row0 + ai * HALF + m * 16) * ldc + col0;
                const f32x4 g0 = acc[ai][0][m][0], g1 = acc[ai][0][m][1], u0 = acc[ai][1][m][0], u1 = acc[ai][1][m][1];
                u32x4 w; w.x = cvt_pk_bf16(silu_f(g0[0]) * u0[0], silu_f(g0[1]) * u0[1]); w.y = cvt_pk_bf16(silu_f(g0[2]) * u0[2], silu_f(g0[3]) * u0[3]);
                w.z = cvt_pk_bf16(silu_f(g1[0]) * u1[0], silu_f(g1[1]) * u1[1]); w.w = cvt_pk_bf16(silu_f(g1[2]) * u1[2], silu_f(g1[3]) * u1[3]);
                *(u32x4*)rowp = w; }
    }
};

struct EpiResid {
    static constexpr bool PERM = false, AFTER_DRAIN = false;
    const float* base; float* out; const float* coef; int cstride; float cmul;
    __device__ __forceinline__ void operator()(const f32x4 (&acc)[2][2][4][2], const Unit& u, int wr, int wc, int fr, int fq) const {
        const int col0 = u.pn * BM + wc * 32 + 4 * fq; const float* cf = coef + (size_t)(u.pm >> 4) * cstride + col0;
        f32x4 cv[2][2];
#pragma unroll
        for (int bj = 0; bj < 2; ++bj)
#pragma unroll
            for (int n = 0; n < 2; ++n) cv[bj][n] = *(const f32x4*)(cf + bj * HALF + n * 16) * cmul;
#pragma unroll
        for (int ai = 0; ai < 2; ++ai)
#pragma unroll
            for (int m = 0; m < 4; ++m) { const size_t off = (size_t)(u.pm * BM + ai * HALF + wr * 64 + m * 16 + fr) * 1024 + col0;
#pragma unroll
                for (int bj = 0; bj < 2; ++bj)
#pragma unroll
                    for (int n = 0; n < 2; ++n) { const f32x4 bs = *(const f32x4*)(base + off + bj * HALF + n * 16); *(f32x4*)(out + off + bj * HALF + n * 16) = bs + cv[bj][n] * acc[ai][bj][m][n]; } }
    }
};

struct EpiProj {
    static constexpr bool PERM = true, AFTER_DRAIN = false;
    bf16_t* P; const float* rot;
    __device__ __forceinline__ void operator()(const f32x4 (&acc)[2][2][4][2], const Unit& u, int wr, int wc, int fr, int fq) const {
        const int T = u.pn; int dst, dst2 = -1, rotm = 0; float sc = 1.f;
        switch (T) {
            case 0: dst = 0; sc = 0.125f; break;
            case 1: dst = 256; break; case 2: dst = 512; break; case 3: dst = 768; break;
            case 4: dst = 1536; dst2 = 1024; sc = 0.18033688011112042f; rotm = 15; break;
            case 5: dst = 1792; dst2 = 1280; sc = 0.18033688011112042f; rotm = 15; break;
            case 6: dst = 2048; break;
            case 7: dst = 2304; rotm = 3; break;
            case 8: dst = 2560; rotm = 3; break;
            case 9: dst = 2816; rotm = 15; break;
            case 10: dst = 3072; rotm = 15; sc = 0.125f; break;
            case 11: dst = 3328; break; case 12: dst = 3584; break;
            default: dst = 3840; break;
        }
        const bool dorot = (rotm >> wc) & 1;
        const int row0 = u.pm * BM + wr * 64 + fr;
#pragma unroll
        for (int ai = 0; ai < 2; ++ai)
#pragma unroll
            for (int m = 0; m < 4; ++m) { const int row = row0 + ai * HALF + m * 16; bf16_t* rowp = P + (size_t)row * 4096 + 64 * wc + 8 * fq;
                f32x4 a0 = acc[ai][0][m][0] * sc, a1 = acc[ai][0][m][1] * sc, b0 = acc[ai][1][m][0] * sc, b1 = acc[ai][1][m][1] * sc;
                if (dst2 >= 0) { u32x4 w; w.x = cvt_pk_bf16(a0[0], a0[1]); w.y = cvt_pk_bf16(a0[2], a0[3]); w.z = cvt_pk_bf16(a1[0], a1[1]); w.w = cvt_pk_bf16(a1[2], a1[3]); *(u32x4*)(rowp + dst2) = w;
                    w.x = cvt_pk_bf16(b0[0], b0[1]); w.y = cvt_pk_bf16(b0[2], b0[3]); w.z = cvt_pk_bf16(b1[0], b1[1]); w.w = cvt_pk_bf16(b1[2], b1[3]); *(u32x4*)(rowp + dst2 + 32) = w; }
                if (dorot) { const float* rp = rot + (size_t)(row & 4095) * 64 + 8 * fq; const f32x4 c0 = *(const f32x4*)rp, c1 = *(const f32x4*)(rp + 4), s0 = *(const f32x4*)(rp + 32), s1 = *(const f32x4*)(rp + 36);
                    const f32x4 y0 = a0 * c0 - b0 * s0, y1 = a1 * c1 - b1 * s1, z0 = a0 * s0 + b0 * c0, z1 = a1 * s1 + b1 * c1; a0 = y0; a1 = y1; b0 = z0; b1 = z1; }
                u32x4 w; w.x = cvt_pk_bf16(a0[0], a0[1]); w.y = cvt_pk_bf16(a0[2], a0[3]); w.z = cvt_pk_bf16(a1[0], a1[1]); w.w = cvt_pk_bf16(a1[2], a1[3]); *(u32x4*)(rowp + dst) = w;
                w.x = cvt_pk_bf16(b0[0], b0[1]); w.y = cvt_pk_bf16(b0[2], b0[3]); w.z = cvt_pk_bf16(b1[0], b1[1]); w.w = cvt_pk_bf16(b1[2], b1[3]); *(u32x4*)(rowp + dst + 32) = w; }
    }
};

template <class Epi, class Sched, bool ALIGN_EPI = false, bool SP2 = false>
__device__ __forceinline__ void gemm_phase(PG8_LAS unsigned char* lds, const Gemm g, const Sched& S, const Epi& E) {
    int tid_ = threadIdx.x; asm volatile("" : "+v"(tid_));
    const int tid = tid_, wid = __builtin_amdgcn_readfirstlane(tid >> 6), lane = tid & 63, wr = wid >> 2, wc = wid & 3, fr = lane & 15, fq = lane >> 4;
    const int K = g.K, nt = K / BK;
    unsigned voffA[2], voffB[2];
#pragma unroll
    for (int i = 0; i < 2; ++i) { int R, C; stage_rc(tid * 16 + i * 8192, R, C); const int Rb = Epi::PERM ? ((R & ~31) + perm32(R & 31)) : R;
        voffA[i] = (unsigned)(R * K + C) * 2u; voffB[i] = (unsigned)(Rb * K + C) * 2u; }
    const size_t kstep = (size_t)(BK * 2);
    const size_t hstep = (size_t)HALF * K * 2;
    const size_t tstep = 2 * hstep;
    const unsigned ldsw = (unsigned)wid * 1024u;
    const int aoff = lds_byte(wr * 64 + fr, fq * 8), boff = lds_byte(wc * 32 + fr, fq * 8);
#define PG8_SA(b, h) (((b) * 2 + (h)) * HTB)
#define PG8_SB(b, h) ((4 + (b) * 2 + (h)) * HTB)
#define PG8_STAGE(bufoff, gbase, voff) do { _Pragma("unroll") for (int _i = 0; _i < 2; ++_i) \
        __builtin_amdgcn_global_load_lds((const unsigned*)((const char*)(gbase) + (voff)[_i]), (PG8_LAS unsigned*)(lds + (bufoff) + ldsw + _i * 8192), 16, 0, 0); } while (0)
#define PG8_LDA(dst, b, h) do { _Pragma("unroll") for (int m = 0; m < 4; ++m) _Pragma("unroll") for (int k = 0; k < 2; ++k) dst[m][k] = *(const PG8_LAS bf16x8*)(lds + PG8_SA(b, h) + aoff + m * 2048 + k * 1024); } while (0)
#define PG8_LDB(dst, b, h) do { _Pragma("unroll") for (int n = 0; n < 2; ++n) _Pragma("unroll") for (int k = 0; k < 2; ++k) dst[n][k] = *(const PG8_LAS bf16x8*)(lds + PG8_SB(b, h) + boff + n * 2048 + k * 1024); } while (0)
#define PG8_MMA(ai, bj, At, Bt) do { __builtin_amdgcn_s_setprio(1); _Pragma("unroll") for (int m = 0; m < 4; ++m) _Pragma("unroll") for (int n = 0; n < 2; ++n) _Pragma("unroll") for (int k = 0; k < 2; ++k) \
        acc[ai][bj][m][n] = __builtin_amdgcn_mfma_f32_16x16x32_bf16(Bt[n][k], At[m][k], acc[ai][bj][m][n], 0, 0, 0); __builtin_amdgcn_s_setprio(0); } while (0)
#define PG8_WAIT_V(n) asm volatile("s_waitcnt vmcnt(" #n ")" ::: "memory")
#define PG8_WAIT_L(n) asm volatile("s_waitcnt lgkmcnt(" #n ")" ::: "memory")
#define PG8_BAR __builtin_amdgcn_s_barrier()
#define PG8_SCHED __builtin_amdgcn_sched_barrier(0)
    Unit cur, nxt; int ui = 0;
    if (!S.next(0, cur)) return;
    f32x4 acc[2][2][4][2];
#pragma unroll
    for (int a = 0; a < 2; ++a)
#pragma unroll
        for (int b = 0; b < 2; ++b)
#pragma unroll
            for (int m = 0; m < 4; ++m)
#pragma unroll
                for (int n = 0; n < 2; ++n) acc[a][b][m][n] = (f32x4){0.f, 0.f, 0.f, 0.f};
    bf16x8 At[4][2], B0[2][2], B1[2][2];
    const char* cA = (const char*)g.A + (size_t)cur.pm * tstep; const char* cB = (const char*)g.Bt + (size_t)cur.pn * tstep;
    S.a_ready(cur);
    if constexpr (SP2) {
        PG8_STAGE(PG8_SB(0, 0), cB, voffB); PG8_STAGE(PG8_SB(0, 1), cB + hstep, voffB); PG8_STAGE(PG8_SA(0, 0), cA, voffA); PG8_STAGE(PG8_SA(0, 1), cA + hstep, voffA);
        if (wr == 1) PG8_BAR;
        PG8_WAIT_V(2); PG8_BAR;
        PG8_STAGE(PG8_SB(1, 0), cB + kstep, voffB); PG8_STAGE(PG8_SA(1, 0), cA + kstep, voffA); PG8_STAGE(PG8_SB(1, 1), cB + hstep + kstep, voffB);
        PG8_WAIT_V(6); PG8_BAR;
    } else {
        PG8_STAGE(PG8_SB(0, 0), cB, voffB); PG8_STAGE(PG8_SA(0, 0), cA, voffA); PG8_STAGE(PG8_SB(0, 1), cB + hstep, voffB); PG8_STAGE(PG8_SA(0, 1), cA + hstep, voffA);
        if (wr == 1) PG8_BAR;
        PG8_WAIT_V(4); PG8_BAR;
        PG8_STAGE(PG8_SB(1, 0), cB + kstep, voffB); PG8_STAGE(PG8_SA(1, 0), cA + kstep, voffA); PG8_STAGE(PG8_SB(1, 1), cB + hstep + kstep, voffB);
        PG8_WAIT_V(6); PG8_BAR;
    }
    for (;;) {
        const bool has_next = S.next(ui + 1, nxt);
        const char* nA = has_next ? (const char*)g.A + (size_t)nxt.pm * tstep : cA; const char* nB = has_next ? (const char*)g.Bt + (size_t)nxt.pn * tstep : cB;
        for (int t = 0; t < nt; t += 2) {
            const bool last = (t == nt - 2);
            const char* a1 = cA + (size_t)(t + 1) * kstep;
            const char* a2 = last ? nA : cA + (size_t)(t + 2) * kstep; const char* b2 = last ? nB : cB + (size_t)(t + 2) * kstep;
            const char* a3 = a2 + kstep; const char* b3 = b2 + kstep;
            if (last && has_next) S.a_ready(nxt);
            if constexpr (SP2) {
            PG8_LDB(B0, 0, 0); PG8_LDB(B1, 0, 1); PG8_SCHED; PG8_LDA(At, 0, 0); PG8_STAGE(PG8_SA(1, 1), a1 + hstep, voffA);
            PG8_WAIT_V(8); PG8_WAIT_L(0); PG8_BAR; PG8_MMA(0, 0, At, B0); PG8_MMA(0, 1, At, B1); PG8_BAR; PG8_SCHED;
            PG8_LDA(At, 0, 1); PG8_STAGE(PG8_SB(0, 0), b2, voffB); PG8_STAGE(PG8_SB(0, 1), b2 + hstep, voffB); PG8_STAGE(PG8_SA(0, 0), a2, voffA);
            PG8_WAIT_V(8); PG8_WAIT_L(0); PG8_BAR; PG8_MMA(1, 0, At, B0); PG8_MMA(1, 1, At, B1); PG8_BAR; PG8_SCHED;
            PG8_LDB(B0, 1, 0); PG8_LDB(B1, 1, 1); PG8_SCHED; PG8_LDA(At, 1, 0); PG8_STAGE(PG8_SA(0, 1), a2 + hstep, voffA);
            PG8_WAIT_V(8); PG8_WAIT_L(0); PG8_BAR; PG8_MMA(0, 0, At, B0); PG8_MMA(0, 1, At, B1); PG8_BAR; PG8_SCHED;
            PG8_LDA(At, 1, 1); PG8_STAGE(PG8_SB(1, 0), b3, voffB); PG8_STAGE(PG8_SB(1, 1), b3 + hstep, voffB); PG8_STAGE(PG8_SA(1, 0), a3, voffA);
            PG8_WAIT_V(8); PG8_WAIT_L(0); PG8_BAR; PG8_MMA(1, 0, At, B0); PG8_MMA(1, 1, At, B1); PG8_BAR; PG8_SCHED;
            } else {
            PG8_LDB(B0, 0, 0); PG8_SCHED; PG8_LDA(At, 0, 0); PG8_STAGE(PG8_SA(1, 1), a1 + hstep, voffA);
            PG8_WAIT_L(8); PG8_BAR; PG8_WAIT_L(0); PG8_MMA(0, 0, At, B0); PG8_BAR; PG8_SCHED;
            PG8_LDB(B1, 0, 1); PG8_STAGE(PG8_SB(0, 0), b2, voffB);
            PG8_BAR; PG8_WAIT_L(0); PG8_MMA(0, 1, At, B1); PG8_BAR;
            PG8_LDA(At, 0, 1); PG8_STAGE(PG8_SA(0, 0), a2, voffA);
            PG8_BAR; PG8_WAIT_L(0); PG8_MMA(1, 0, At, B0); PG8_BAR; PG8_SCHED;
            PG8_STAGE(PG8_SB(0, 1), b2 + hstep, voffB);
            PG8_WAIT_V(6); PG8_BAR; PG8_MMA(1, 1, At, B1); PG8_BAR;
            PG8_LDB(B0, 1, 0); PG8_SCHED; PG8_LDA(At, 1, 0); PG8_STAGE(PG8_SA(0, 1), a2 + hstep, voffA);
            PG8_WAIT_L(8); PG8_BAR; PG8_WAIT_L(0); PG8_MMA(0, 0, At, B0); PG8_BAR; PG8_SCHED;
            PG8_LDB(B1, 1, 1); PG8_STAGE(PG8_SB(1, 0), b3, voffB);
            PG8_BAR; PG8_WAIT_L(0); PG8_MMA(0, 1, At, B1); PG8_BAR;
            PG8_LDA(At, 1, 1); PG8_STAGE(PG8_SA(1, 0), a3, voffA);
            PG8_BAR; PG8_WAIT_L(0); PG8_MMA(1, 0, At, B0); PG8_BAR; PG8_SCHED;
            PG8_STAGE(PG8_SB(1, 1), b3 + hstep, voffB);
            PG8_WAIT_V(6); PG8_BAR; PG8_MMA(1, 1, At, B1); PG8_BAR;
            }
        }
        if constexpr (ALIGN_EPI) { if (wr == 0) PG8_BAR; }
        if constexpr (!Epi::AFTER_DRAIN) { E(acc, cur, wr, wc, fr, fq); S.done(cur); }
        if (!has_next) break;
#pragma unroll
        for (int a = 0; a < 2; ++a)
#pragma unroll
            for (int b = 0; b < 2; ++b)
#pragma unroll
                for (int m = 0; m < 4; ++m)
#pragma unroll
                    for (int n = 0; n < 2; ++n) acc[a][b][m][n] = (f32x4){0.f, 0.f, 0.f, 0.f};
        cur = nxt; cA = nA; cB = nB; ++ui;
        if constexpr (ALIGN_EPI) { if (wr == 1) PG8_BAR; }
    }
    PG8_WAIT_V(0);
    if constexpr (!ALIGN_EPI) { if (wr == 0) PG8_BAR; }
    PG8_BAR;
    if constexpr (Epi::AFTER_DRAIN) { E.fused(acc, cur, wr, wc, fr, fq, lds, wid, lane); S.done(cur); }
#undef PG8_SA
#undef PG8_SB
#undef PG8_STAGE
#undef PG8_LDA
#undef PG8_LDB
#undef PG8_MMA
#undef PG8_WAIT_V
#undef PG8_WAIT_L
#undef PG8_BAR
#undef PG8_SCHED
}
}

constexpr int NWAVES = 8;
#ifndef MK_ONE_LAUNCH
#define MK_ONE_LAUNCH 0
#endif
constexpr bool ONE_LAUNCH = MK_ONE_LAUNCH != 0;

constexpr int NB = 4, SEQ = 4096, D = 1024, NL = 4, FF = 2816, INW = 3368, NPROJ = 3584, PP = 4096, NADA = 9;
constexpr int M = NB * SEQ;
constexpr float NORM_EPS = 1e-6f;
constexpr int PC_GQ = 0, PC_GK = 256, PC_GV = 512, PC_GG = 768, PC_NQRAW = 1024, PC_NQROT = 1536, PC_NKC = 2048, PC_NVC = 2176, PC_NKS = 2304, PC_NVS = 2432, PC_NKW = 2560, PC_NVW = 2688,
              PC_RQ = 2816, PC_RK = 3072, PC_RV = 3328, PC_RG = 3584, PC_GLR = 3840, PC_NGATE = 3856;

constexpr size_t MiB = 1u << 20;
constexpr size_t WS_CTL = 0, CTL_ZERO_BYTES = 1 * MiB;
constexpr size_t WS_MOD = 1 * MiB;
constexpr size_t WS_ROT = 2 * MiB;
constexpr size_t WS_KC = 3 * MiB;
constexpr size_t WS_GDEC = 3 * MiB + 512 * 1024;
constexpr size_t WS_PTRS = 3 * MiB + 768 * 1024;
constexpr size_t WS_W = 4 * MiB;
constexpr size_t W_LAYER = 42 * MiB;
constexpr size_t WO_F1IN = 0, WO_F1OUT = (size_t)5632 * 1024 * 2, WO_WIN = WO_F1OUT + (size_t)1024 * 2816 * 2, WO_WOUT = WO_WIN + (size_t)NPROJ * 1024 * 2,
                 WO_F2IN = WO_WOUT + (size_t)1024 * 1024 * 2, WO_F2OUT = WO_F2IN + (size_t)5632 * 1024 * 2;
static_assert(WO_F2OUT + (size_t)1024 * 2816 * 2 == W_LAYER, "weight map");
constexpr size_t WS_H = 172 * MiB;
constexpr size_t WS_MIX = 204 * MiB;
constexpr size_t WS_KVG = 236 * MiB, WS_KVR = 252 * MiB;
constexpr size_t WS_P = 268 * MiB;
constexpr size_t WS_END = 396 * MiB;

constexpr int RING_OFF = 0, RING_BYTES = 131072;
constexpr int LDSCTL_OFF = RING_BYTES, MISC_OFF = LDSCTL_OFF + 320;
constexpr int LDS_BYTES = 147456;
static_assert(MISC_OFF + 128 <= LDS_BYTES, "LDS map");

#define GAS __attribute__((address_space(1)))
#define LAS __attribute__((address_space(3)))
typedef unsigned short bf16;
typedef unsigned v4u __attribute__((ext_vector_type(4)));
typedef float f32x4 __attribute__((ext_vector_type(4)));
typedef short bf16x8 __attribute__((ext_vector_type(8)));
typedef GAS unsigned gu32;
typedef GAS unsigned long long gu64;
#define RLX_AGENT __ATOMIC_RELAXED, __HIP_MEMORY_SCOPE_AGENT
#define LDS_WAIT() asm volatile("s_waitcnt lgkmcnt(0)" ::: "memory")
#define VM_WAIT() asm volatile("s_waitcnt vmcnt(0)" ::: "memory")
__device__ __forceinline__ unsigned long long rt() { return __builtin_amdgcn_s_memrealtime(); }
__device__ __forceinline__ unsigned f2bf(float f) { unsigned u = __builtin_bit_cast(unsigned, f); return (u + 0x7fffu + ((u >> 16) & 1u)) >> 16; }
__device__ __forceinline__ unsigned pk2(float lo, float hi) { return f2bf(lo) | (f2bf(hi) << 16); }

#define XB_TMO      128
#define XB_XCNT(j)  (256  + 64 * (j))
#define XB_XSUB(j)  (1280 + 64 * (j))
#define XB_XGEN(j)  (2304 + 64 * (j))
#define XB_TOP      3328
#define XB_TOPGEN   3392
#define XCD_BAR_WORDS 3456
#define XB_SPIN_CAP (1u << 18)

__device__ __forceinline__ unsigned xb_ld(unsigned* p)              { return __hip_atomic_load(p, __ATOMIC_RELAXED, __HIP_MEMORY_SCOPE_AGENT); }
__device__ __forceinline__ unsigned xb_add(unsigned* p, unsigned v) { return __hip_atomic_fetch_add(p, v, __ATOMIC_RELAXED, __HIP_MEMORY_SCOPE_AGENT); }
__device__ __forceinline__ unsigned xb_xcc_id() { return (unsigned)__builtin_amdgcn_s_getreg((3 << 11) | 20) & 0xFu; }
#define XB_SPIN(cond, bar) do { unsigned _sp = 0; while (cond) { __builtin_amdgcn_s_sleep(1); \
    if ((++_sp & 255u) == 0u) { if (xb_ld(&(bar)[XB_TMO])) break; if (_sp > XB_SPIN_CAP) { atomicAdd(&(bar)[XB_TMO], 1u); break; } } } } while (0)

struct XcdBarrier {
    unsigned* bar; unsigned x;
    volatile LAS unsigned* st;
};

__device__ __forceinline__ XcdBarrier xcd_barrier_post(unsigned* bar, volatile LAS unsigned* st) {
    XcdBarrier b; b.bar = bar; b.x = xb_xcc_id(); b.st = st;
    if (threadIdx.x == 0) (void)xb_add(&bar[XB_XCNT(b.x)], 1u);
    return b;
}
__device__ __forceinline__ void xcd_barrier_complete(unsigned* bar, unsigned x, unsigned& nloc, unsigned& nx) {
    const unsigned G = gridDim.x * gridDim.y * gridDim.z;
    unsigned sum, cnt, mine, sp = 0u;
    for (;;) {
        sum = 0u; cnt = 0u; mine = 0u;
#pragma unroll
        for (unsigned j = 0; j < 16; ++j) { const unsigned c = xb_ld(&bar[XB_XCNT(j)]); sum += c; cnt += (c > 0u) ? 1u : 0u; mine = (j == x) ? c : mine; }
        if (sum == G) break;
        __builtin_amdgcn_s_sleep(1);
        if ((++sp & 255u) == 0u) { if (xb_ld(&bar[XB_TMO])) break; if (sp > XB_SPIN_CAP) { atomicAdd(&bar[XB_TMO], 1u); break; } }
    }
    nloc = mine > 0u ? mine : 1u; nx = cnt > 0u ? cnt : 1u;
}

__device__ __forceinline__ void xcd_barrier(const XcdBarrier& b) {
    asm volatile("s_waitcnt vmcnt(0)" ::: "memory");
    __syncthreads();
    if (threadIdx.x == 0) {
        unsigned* bar = b.bar;
        __builtin_amdgcn_s_waitcnt(0);
        unsigned nloc = b.st[0], nx = b.st[1];
        if (nloc == 0u) { xcd_barrier_complete(bar, b.x, nloc, nx); b.st[0] = nloc; b.st[1] = nx; }
        const unsigned old = xb_add(&bar[XB_XSUB(b.x)], 1u);
        const unsigned gen = old / nloc;
        if (old + 1u == (gen + 1u) * nloc) {
            __builtin_amdgcn_fence(__ATOMIC_RELEASE, "agent");
            asm volatile("s_waitcnt vmcnt(0)" ::: "memory");
            const unsigned og = xb_add(&bar[XB_TOP], 1u);
            const unsigned tg = og / nx;
            if (og + 1u == (tg + 1u) * nx) xb_add(&bar[XB_TOPGEN], 1u);
            else XB_SPIN(xb_ld(&bar[XB_TOPGEN]) == tg, bar);
            __builtin_amdgcn_fence(__ATOMIC_ACQUIRE, "agent");
            xb_add(&bar[XB_XGEN(b.x)], 1u);
            asm volatile("s_waitcnt vmcnt(0)" ::: "memory");
        } else {
            XB_SPIN(xb_ld(&bar[XB_XGEN(b.x)]) == gen, bar);
            __builtin_amdgcn_fence(__ATOMIC_ACQUIRE, "agent");
            asm volatile("s_waitcnt vmcnt(0)" ::: "memory");
        }
    }
    __syncthreads();
}

struct Frame {
    LAS unsigned char* lds;
    volatile LAS unsigned* MISC;
    gu32* ctl;
    int tid, lane, wave;
    int vcu, G;
    const float* const* in;
    unsigned char* ws;
};
__device__ __forceinline__ float bf2f(bf16 u) { return __uint_as_float((unsigned)u << 16); }
__device__ __forceinline__ bf16 f2b(float f) { return (bf16)f2bf(f); }
__device__ __forceinline__ float wave_sum(float v) {
#pragma unroll
    for (int o = 1; o < 64; o <<= 1) v += __shfl_xor(v, o);
    return v;
}
__device__ __forceinline__ float wave_max(float v) {
#pragma unroll
    for (int o = 1; o < 64; o <<= 1) v = fmaxf(v, __shfl_xor(v, o));
    return v;
}
__device__ __forceinline__ float silu1(float x) { return x / (1.0f + __expf(-x)); }
__device__ __forceinline__ float sigmoid1(float x) { return 1.0f / (1.0f + __expf(-x)); }

template <class Map>
__device__ __forceinline__ void p0_transpose_item(const float* W, int K, int N, bf16* WT, int NT, LAS float* scr, int item, int lane, Map srcmap) {
    const int nblk = NT / 32, kb = item / nblk, nb = item % nblk, k0 = 64 * kb, n0 = 32 * nb;
    const int sc = srcmap(n0 + (lane & 31));
#pragma unroll 8
    for (int i = 0; i < 32; ++i) { const int kk = 2 * i + (lane >> 5); scr[kk * 33 + (lane & 31)] = sc >= 0 ? W[(size_t)(k0 + kk) * N + sc] : 0.f; }
    LDS_WAIT(); asm volatile("" ::: "memory");
    const int c = lane & 7;
#pragma unroll
    for (int j = 0; j < 4; ++j) { const int n = (lane >> 3) + 8 * j; const LAS float* s = scr + (8 * c) * 33 + n;
        v4u o; o.x = pk2(s[0 * 33], s[1 * 33]); o.y = pk2(s[2 * 33], s[3 * 33]); o.z = pk2(s[4 * 33], s[5 * 33]); o.w = pk2(s[6 * 33], s[7 * 33]);
        *(GAS v4u*)(WT + (size_t)(n0 + n) * K + k0 + 8 * c) = o; }
    LDS_WAIT(); asm volatile("" ::: "memory");
}
struct MapId { __device__ __forceinline__ int operator()(int n) const { return n; } };
struct MapFfnIn { __device__ __forceinline__ int operator()(int n) const { const int t = n >> 8, c = n & 255; return (c >> 7) * FF + 128 * t + (c & 127); } };
struct MapWin { __device__ __forceinline__ int operator()(int n) const {
    const int T = n >> 8, c = n & 255, o = 64 * ((c & 127) >> 5) + 32 * (c >> 7) + (c & 31);
    switch (T) { case 0: return o; case 1: return 256 + o; case 2: return 512 + o; case 3: return 768 + o; case 4: return 1040 + o; case 5: return 1296 + o; case 6: return 1552 + o; case 7: return 1808 + o;
                 case 8: return 2064 + o; case 9: return 2344 + o; case 10: return 2600 + o; case 11: return 2856 + o; case 12: return 3112 + o;
                 default: return o < 16 ? 1024 + o : (o < 40 ? 2320 + (o - 16) : -1); } } };

__device__ const double INV_FREQ[32] = {1.0,0.7498942093324559,0.5623413251903491,0.4216965034285822,0.31622776601683794,0.23713737056616552,0.1778279410038923,0.1333521432163324,0.1,0.07498942093324558,0.05623413251903491,0.042169650342858224,0.03162277660168379,0.023713737056616554,0.01778279410038923,0.01333521432163324,0.01,0.007498942093324558,0.005623413251903491,0.004216965034285823,0.0031622776601683794,0.0023713737056616554,0.0017782794100389228,0.001333521432163324,0.001,0.0007498942093324559,0.0005623413251903491,0.00042169650342858224,0.00031622776601683794,0.00023713737056616554,0.00017782794100389227,0.0001333521432163324};

struct Ptrs {
    const float *x, *c, *w_ada, *b_ada, *norm_g, *ffn1_in, *ffn1_out, *w_in, *gla_a2, *gla_a_bias, *gla_norm_g, *nsa_pe_k, *nsa_pe_v, *nsa_w1_k, *nsa_w2_k, *nsa_w1_v, *nsa_w2_v, *nsa_gate_bias, *ret_norm_g, *w_out, *ffn2_in, *ffn2_out, *final_norm_g;
};

__device__ __forceinline__ void p_prologue(Frame& F, const Ptrs& I) {
    LAS float* scr = (LAS float*)(F.lds + RING_OFF + F.wave * 16384);
    const int gw = F.vcu * NWAVES + F.wave, NGW = F.G * NWAVES;
    constexpr int I_FIN = (D / 64) * (2 * FF / 32), I_FOUT = (FF / 64) * (D / 32), I_WIN = (D / 64) * (NPROJ / 32), I_WOUT = (D / 64) * (D / 32);
    constexpr int I_LAYER = 2 * I_FIN + 2 * I_FOUT + I_WIN + I_WOUT;
    for (int it = gw; it < NL * I_LAYER; it += NGW) {
        const int l = it / I_LAYER; int r = it % I_LAYER;
        unsigned char* wl = F.ws + WS_W + (size_t)l * W_LAYER;
        if (r < I_FIN) { p0_transpose_item(I.ffn1_in + (size_t)l * D * 2 * FF, D, 2 * FF, (bf16*)(wl + WO_F1IN), 2 * FF, scr, r, F.lane, MapFfnIn()); continue; } r -= I_FIN;
        if (r < I_FIN) { p0_transpose_item(I.ffn2_in + (size_t)l * D * 2 * FF, D, 2 * FF, (bf16*)(wl + WO_F2IN), 2 * FF, scr, r, F.lane, MapFfnIn()); continue; } r -= I_FIN;
        if (r < I_FOUT) { p0_transpose_item(I.ffn1_out + (size_t)l * FF * D, FF, D, (bf16*)(wl + WO_F1OUT), D, scr, r, F.lane, MapId()); continue; } r -= I_FOUT;
        if (r < I_FOUT) { p0_transpose_item(I.ffn2_out + (size_t)l * FF * D, FF, D, (bf16*)(wl + WO_F2OUT), D, scr, r, F.lane, MapId()); continue; } r -= I_FOUT;
        if (r < I_WIN) { p0_transpose_item(I.w_in + (size_t)l * D * INW, D, INW, (bf16*)(wl + WO_WIN), NPROJ, scr, r, F.lane, MapWin()); continue; } r -= I_WIN;
        p0_transpose_item(I.w_out + (size_t)l * D * D, D, D, (bf16*)(wl + WO_WOUT), D, scr, r, F.lane, MapId());
    }
    __syncthreads();
    {
        float* rot = (float*)(F.ws + WS_ROT);
        for (int e = (int)blockIdx.x * 512 + F.tid; e < 4096 * 32; e += F.G * 512) {
            const int t = e >> 5, d = e & 31;
            const double a = (double)t * INV_FREQ[d];
            const double kq = __builtin_rint(a * 0.63661977236758134308);
            const double r = (a - kq * 1.57079632679489655800e+00) - kq * 6.12323399573676603587e-17;
            const double r2 = r * r;
            const double sn = r * (1.0 + r2 * (-1.0 / 6 + r2 * (1.0 / 120 + r2 * (-1.0 / 5040 + r2 * (1.0 / 362880 + r2 * (-1.0 / 39916800 + r2 * (1.0 / 6227020800.0)))))));
            const double cs = 1.0 + r2 * (-0.5 + r2 * (1.0 / 24 + r2 * (-1.0 / 720 + r2 * (1.0 / 40320 + r2 * (-1.0 / 3628800 + r2 * (1.0 / 479001600.0 + r2 * (-1.0 / 87178291200.0)))))));
            const int q = ((int)kq) & 3;
            const double c = (q == 0) ? cs : (q == 1) ? -sn : (q == 2) ? -cs : sn;
            const double s = (q == 0) ? sn : (q == 1) ? cs : (q == 2) ? -sn : -cs;
            rot[t * 64 + d] = (float)c; rot[t * 64 + 32 + d] = (float)s;
        }
    }
    {
        LAS float* ca = (LAS float*)(F.lds + RING_OFF);
        LAS float* part = ca + 4096;
        for (int e = F.tid; e < 4096; e += 512) ca[e] = silu1(I.c[e]);
        __syncthreads();
        float* mod = (float*)(F.ws + WS_MOD);
        constexpr int NJG = NADA * D / 64;
        for (int it = (int)blockIdx.x; it < NL * NJG; it += F.G) {
            const int l = it / NJG, jg = it % NJG, j = jg * 64 + F.lane;
            const float* wp = I.w_ada + (size_t)l * D * (NADA * D) + (size_t)(128 * F.wave) * (NADA * D) + j;
            float a0 = 0.f, a1 = 0.f, a2 = 0.f, a3 = 0.f;
#pragma unroll 8
            for (int k = 0; k < 128; ++k) { const float w = wp[(size_t)k * (NADA * D)]; const int kk = 128 * F.wave + k;
                a0 += ca[kk] * w; a1 += ca[1024 + kk] * w; a2 += ca[2048 + kk] * w; a3 += ca[3072 + kk] * w; }
            part[(F.wave * 4 + 0) * 64 + F.lane] = a0; part[(F.wave * 4 + 1) * 64 + F.lane] = a1; part[(F.wave * 4 + 2) * 64 + F.lane] = a2; part[(F.wave * 4 + 3) * 64 + F.lane] = a3;
            __syncthreads();
            if (F.tid < 256) { const int b = F.tid >> 6, ln = F.tid & 63; float s = I.b_ada[(size_t)l * NADA * D + jg * 64 + ln];
#pragma unroll
                for (int w = 0; w < 8; ++w) s += part[(w * 4 + b) * 64 + ln];
                mod[((size_t)l * NB + b) * (NADA * D) + jg * 64 + ln] = s; }
            __syncthreads();
        }
    }
}

__device__ __forceinline__ void p_norm(Frame& F, const float* x, const float* g, const float* modl  , int sub, bf16* H) {
    const int gw = F.vcu * NWAVES + F.wave, NGW = F.G * NWAVES;
    f32x4 gv[4];
#pragma unroll
    for (int j = 0; j < 4; ++j) gv[j] = *(const f32x4*)(g + 4 * F.lane + 256 * j);
    for (int m = gw; m < M; m += NGW) {
        const int b = m >> 12;
        const float* sh = modl + (size_t)b * (NADA * D) + (3 * sub) * D; const float* sc = sh + D;
        const GAS f32x4* xr = (const GAS f32x4*)(x + (size_t)m * D) + F.lane;
        f32x4 v[4]; float s = 0.f;
#pragma unroll
        for (int j = 0; j < 4; ++j) { v[j] = xr[64 * j]; s += (v[j].x * v[j].x + v[j].y * v[j].y) + (v[j].z * v[j].z + v[j].w * v[j].w); }
        const float rstd = 1.f / sqrtf(wave_sum(s) * (1.f / D) + NORM_EPS);
        GAS unsigned long long* o8 = (GAS unsigned long long*)(H + (size_t)m * D) + F.lane;
#pragma unroll
        for (int j = 0; j < 4; ++j) { const f32x4 scv = *(const f32x4*)(sc + 4 * F.lane + 256 * j), shv = *(const f32x4*)(sh + 4 * F.lane + 256 * j);
            const f32x4 y = v[j] * rstd * gv[j] * (scv + 1.0f) + shv;
            o8[64 * j] = (unsigned long long)pk2(y.x, y.y) | ((unsigned long long)pk2(y.z, y.w) << 32); }
    }
}
__device__ __forceinline__ void p_final(Frame& F, float* x, const float* g) {
    const int gw = F.vcu * NWAVES + F.wave, NGW = F.G * NWAVES;
    f32x4 gv[4];
#pragma unroll
    for (int j = 0; j < 4; ++j) gv[j] = *(const f32x4*)(g + 4 * F.lane + 256 * j);
    for (int m = gw; m < M; m += NGW) {
        GAS f32x4* xr = (GAS f32x4*)(x + (size_t)m * D) + F.lane;
        f32x4 v[4]; float s = 0.f;
#pragma unroll
        for (int j = 0; j < 4; ++j) { v[j] = xr[64 * j]; s += (v[j].x * v[j].x + v[j].y * v[j].y) + (v[j].z * v[j].z + v[j].w * v[j].w); }
        const float rstd = 1.f / sqrtf(wave_sum(s) * (1.f / D) + NORM_EPS);
#pragma unroll
        for (int j = 0; j < 4; ++j) xr[64 * j] = v[j] * rstd * gv[j];
    }
}

constexpr int LP = 65;
template <bool FULL>
__device__ __forceinline__ void gla_unit_naive(Frame& F, const Ptrs& I, int l, int u) {
    LAS float* Q = (LAS float*)(F.lds + RING_OFF); LAS float* K = Q + 64 * LP; LAS float* V = K + 64 * LP; LAS float* Bc = V + 64 * LP; LAS float* At = Bc + 64 * LP; LAS float* GL = At + 64 * LP;
    const int n = u & 63, h = (u >> 6) & 3, b = u >> 8, row0 = b * SEQ + 64 * n, tid = F.tid;
    const bf16* P = (const bf16*)(F.ws + WS_P);
    float* KVG = (float*)(F.ws + WS_KVG) + (size_t)u * 4096; float* DEC = (float*)(F.ws + WS_GDEC) + u * 64;
    for (int idx = tid; idx < 4096; idx += 512) { const int i = idx >> 6, d = idx & 63; const bf16* pr = P + (size_t)(row0 + i) * PP + 64 * h + d;
        Q[i * LP + d] = bf2f(pr[PC_GQ]); K[i * LP + d] = bf2f(pr[PC_GK]); V[i * LP + d] = bf2f(pr[PC_GV]); }
    for (int idx = tid; idx < 1024; idx += 512) { const int i = idx >> 4, j = idx & 15; GL[i * 16 + j] = bf2f(P[(size_t)(row0 + i) * PP + PC_GLR + j]); }
    __syncthreads();
    const float* a2 = I.gla_a2 + (size_t)l * 16 * 256 + 64 * h; const float* ab = I.gla_a_bias + (size_t)l * 256 + 64 * h;
    for (int idx = tid; idx < 4096; idx += 512) { const int i = idx >> 6, d = idx & 63; float z = ab[d];
#pragma unroll
        for (int j = 0; j < 16; ++j) z += GL[i * 16 + j] * a2[j * 256 + d];
        Bc[i * LP + d] = (fminf(z, 0.f) - log1pf(expf(-fabsf(z)))) * (1.0f / 16.0f); }
    __syncthreads();
    if (tid < 64) { float run = 0.f; for (int i = 0; i < 64; ++i) { run += Bc[i * LP + tid]; Bc[i * LP + tid] = run; } }
    __syncthreads();
    for (int idx = tid; idx < 4096; idx += 512) { const int i = idx >> 6, d = idx & 63; const float bb = Bc[i * LP + d]; Q[i * LP + d] *= expf(bb); K[i * LP + d] *= expf(-bb); }
    __syncthreads();
    if constexpr (!FULL) {
        for (int idx = tid; idx < 4096; idx += 512) { const int d = idx >> 6, v = idx & 63; float s = 0.f;
            for (int j = 0; j < 64; ++j) s += K[j * LP + d] * V[j * LP + v];
            KVG[d * 64 + v] = expf(Bc[63 * LP + d]) * s; }
        if (tid < 64) DEC[tid] = expf(Bc[63 * LP + tid]);
    } else {
        for (int idx = tid; idx < 4096; idx += 512) { const int i = idx >> 6, j = idx & 63; float s = 0.f;
            if (j <= i) { for (int d = 0; d < 64; ++d) s += Q[i * LP + d] * K[j * LP + d]; }
            At[i * LP + j] = s; }
        __syncthreads();
        const float* gn = I.gla_norm_g + (size_t)l * 64; bf16* MIX = (bf16*)(F.ws + WS_MIX);
        for (int idx = tid; idx < 4096; idx += 512) { const int i = idx >> 6, v = idx & 63; float o = 0.f;
            for (int j = 0; j <= i; ++j) o += At[i * LP + j] * V[j * LP + v];
            for (int d = 0; d < 64; ++d) o += Q[i * LP + d] * KVG[d * 64 + v];
            const float ms = wave_sum(o * o) * (1.0f / 64.0f);
            const float y = o * (1.f / sqrtf(ms + NORM_EPS)) * gn[v];
            const float gg = bf2f(P[(size_t)(row0 + i) * PP + PC_GG + 64 * h + v]);
            MIX[(size_t)(row0 + i) * D + 64 * h + v] = f2b(y * silu1(gg)); }
    }
    __syncthreads();
}
template <bool FULL>
__device__ __forceinline__ void ret_unit_naive(Frame& F, const Ptrs& I, int l, int u) {
    LAS float* Q = (LAS float*)(F.lds + RING_OFF); LAS float* K = Q + 64 * LP; LAS float* V = K + 64 * LP; LAS float* At = V + 64 * LP;
    const int n = u & 63, h = (u >> 6) & 3, b = u >> 8, row0 = b * SEQ + 64 * n, tid = F.tid;
    const bf16* P = (const bf16*)(F.ws + WS_P);
    float* KVR = (float*)(F.ws + WS_KVR) + (size_t)u * 4096;
    const float lg = log1pf(-exp2f(-5.0f - (float)h));
    for (int idx = tid; idx < 4096; idx += 512) { const int i = idx >> 6, d = idx & 63; const bf16* pr = P + (size_t)(row0 + i) * PP + 64 * h + d;
        Q[i * LP + d] = bf2f(pr[PC_RQ]); K[i * LP + d] = bf2f(pr[PC_RK]); V[i * LP + d] = bf2f(pr[PC_RV]); }
    __syncthreads();
    if constexpr (!FULL) {
        for (int idx = tid; idx < 4096; idx += 512) { const int d = idx >> 6, v = idx & 63; float s = 0.f;
            for (int j = 0; j < 64; ++j) s += K[j * LP + d] * expf(lg * (float)(63 - j)) * V[j * LP + v];
            KVR[d * 64 + v] = s; }
    } else {
        for (int idx = tid; idx < 4096; idx += 512) { const int i = idx >> 6, j = idx & 63; float s = 0.f;
            if (j <= i) { for (int d = 0; d < 64; ++d) s += Q[i * LP + d] * K[j * LP + d]; s *= expf(lg * (float)(i - j)); }
            At[i * LP + j] = s; }
        __syncthreads();
        const float* gn = I.ret_norm_g + (size_t)l * 64; bf16* MIX = (bf16*)(F.ws + WS_MIX);
        for (int idx = tid; idx < 4096; idx += 512) { const int i = idx >> 6, v = idx & 63; float o = 0.f, o2 = 0.f;
            for (int j = 0; j <= i; ++j) o += At[i * LP + j] * V[j * LP + v];
            for (int d = 0; d < 64; ++d) o2 += Q[i * LP + d] * KVR[d * 64 + v];
            o += o2 * expf(lg * (float)(i + 1));
            const float mean = wave_sum(o) * (1.0f / 64.0f); const float xc = o - mean;
            const float var = wave_sum(xc * xc) * (1.0f / 64.0f);
            const float y = xc * (1.f / sqrtf(var + NORM_EPS)) * gn[v];
            const float gg = bf2f(P[(size_t)(row0 + i) * PP + PC_RG + 64 * h + v]);
            MIX[(size_t)(row0 + i) * D + 768 + 64 * h + v] = f2b(y * silu1(gg)); }
    }
    __syncthreads();
}
__device__ __forceinline__ void p_scan(Frame& F) {
    float* KVG = (float*)(F.ws + WS_KVG); float* KVR = (float*)(F.ws + WS_KVR); const float* DEC = (const float*)(F.ws + WS_GDEC);
    for (int e = (int)blockIdx.x * 512 + F.tid; e < 2 * 16 * 4096; e += F.G * 512) {
        const int which = e >> 16, bh = (e >> 12) & 15, dv = e & 4095, d = dv >> 6;
        float s = 0.f;
        if (which == 0) { for (int n = 0; n < 64; ++n) { const int u = bh * 64 + n; const float kv = KVG[(size_t)u * 4096 + dv]; const float dec = DEC[u * 64 + d]; KVG[(size_t)u * 4096 + dv] = s; s = s * dec + kv; } }
        else { const float dec = expf(64.0f * log1pf(-exp2f(-5.0f - (float)(bh & 3))));
               for (int n = 0; n < 64; ++n) { const int u = bh * 64 + n; const float kv = KVR[(size_t)u * 4096 + dv]; KVR[(size_t)u * 4096 + dv] = s; s = s * dec + kv; } }
    }
}
__device__ __forceinline__ void cmp_unit_naive(Frame& F, const Ptrs& I, int l, int u) {
    LAS float* TK = (LAS float*)(F.lds + RING_OFF);
    LAS float* PE = TK + 144 * 64;
    LAS float* HID = PE + 2048;
    const int which = u >> 8, bg = (u >> 5) & 7, ng = u & 31, b = bg >> 1, g = bg & 1, tid = F.tid;
    const bf16* P = (const bf16*)(F.ws + WS_P) + (which ? PC_NVC : PC_NKC) + 64 * g;
    const float* pe = (which ? I.nsa_pe_v : I.nsa_pe_k) + (size_t)l * 2048; const float* w1 = (which ? I.nsa_w1_v : I.nsa_w1_k) + (size_t)l * 2048 * 128; const float* w2 = (which ? I.nsa_w2_v : I.nsa_w2_k) + (size_t)l * 128 * 64;
    bf16* KC = (bf16*)(F.ws + WS_KC) + (size_t)which * (NB * 2 * 256 * 64) + (size_t)bg * 256 * 64;
    const int t0 = 128 * ng;
    for (int idx = tid; idx < 144 * 64; idx += 512) { const int tt = idx >> 6, d = idx & 63; const int t = t0 + tt; TK[idx] = t < SEQ ? bf2f(P[(size_t)(b * SEQ + t) * PP + d]) : 0.f; }
    for (int idx = tid; idx < 2048; idx += 512) PE[idx] = pe[idx];
    __syncthreads();
    { const int j = tid & 127, rg = tid >> 7; float a0 = 0.f, a1 = 0.f; const LAS float* r0 = TK + (16 * (2 * rg)) * 64; const LAS float* r1 = TK + (16 * (2 * rg + 1)) * 64;
      for (int i = 0; i < 2048; ++i) { const float w = w1[(size_t)i * 128 + j]; const float p = PE[i]; a0 += (r0[i] + p) * w; a1 += (r1[i] + p) * w; }
      HID[(2 * rg) * 128 + j] = silu1(a0); HID[(2 * rg + 1) * 128 + j] = silu1(a1); }
    __syncthreads();
    { const int r = tid >> 6, d = tid & 63; float s = 0.f;
      for (int j = 0; j < 128; ++j) s += HID[r * 128 + j] * w2[j * 64 + d];
      const int n = 8 * ng + r; KC[(size_t)n * 64 + d] = n < 255 ? f2b(s) : (bf16)0; }
    __syncthreads();
}
__device__ __forceinline__ void nsa_unit_naive(Frame& F, const Ptrs& I, int l, int b, int g, int t, LAS float* wl) {
    const int lane = F.lane; const int row = b * SEQ + t;
    const bf16* P = (const bf16*)(F.ws + WS_P);
    LAS float* qraw = wl; LAS float* qrot = wl + 256; LAS float* pb = wl + 512;
#pragma unroll
    for (int r = 0; r < 4; ++r) { qraw[r * 64 + lane] = bf2f(P[(size_t)row * PP + PC_NQRAW + 64 * (4 * g + r) + lane]); qrot[r * 64 + lane] = bf2f(P[(size_t)row * PP + PC_NQROT + 64 * (4 * g + r) + lane]); }
    const bf16* KCb = (const bf16*)(F.ws + WS_KC) + (size_t)(b * 2 + g) * 256 * 64; const bf16* VCb = KCb + (size_t)NB * 2 * 256 * 64;
    const int nvalid = (t >= 31) ? min(255, ((t - 31) >> 4) + 1) : 0;
    float sc[4][4];
#pragma unroll
    for (int it = 0; it < 4; ++it) { const int n = it * 64 + lane; float d0 = 0.f, d1 = 0.f, d2 = 0.f, d3 = 0.f;
#pragma unroll 2
        for (int d = 0; d < 64; d += 8) { const v4u kk = *(const v4u*)(KCb + (size_t)n * 64 + d); const unsigned kw[4] = {kk.x, kk.y, kk.z, kk.w};
#pragma unroll
            for (int e = 0; e < 4; ++e) { const float k0 = __uint_as_float(kw[e] << 16), k1 = __uint_as_float(kw[e] & 0xffff0000u); const int dd = d + 2 * e;
                d0 += qraw[dd] * k0 + qraw[dd + 1] * k1; d1 += qraw[64 + dd] * k0 + qraw[64 + dd + 1] * k1; d2 += qraw[128 + dd] * k0 + qraw[128 + dd + 1] * k1; d3 += qraw[192 + dd] * k0 + qraw[192 + dd + 1] * k1; } }
        const bool ok = n < nvalid; sc[it][0] = ok ? d0 : -1e30f; sc[it][1] = ok ? d1 : -1e30f; sc[it][2] = ok ? d2 : -1e30f; sc[it][3] = ok ? d3 : -1e30f; }
    float ocmp[4];
#pragma unroll
    for (int r = 0; r < 4; ++r) { float m = wave_max(fmaxf(fmaxf(sc[0][r], sc[1][r]), fmaxf(sc[2][r], sc[3][r]))); float p[4]; float s = 0.f;
#pragma unroll
        for (int it = 0; it < 4; ++it) { p[it] = (it * 64 + lane < nvalid) ? exp2f(sc[it][r] - m) : 0.f; s += p[it]; }
        s = wave_sum(s); const float inv = s > 0.f ? 1.0f / s : 0.f;
#pragma unroll
        for (int it = 0; it < 4; ++it) pb[r * 256 + it * 64 + lane] = p[it] * inv; }
#pragma unroll
    for (int r = 0; r < 4; ++r) ocmp[r] = 0.f;
#pragma unroll 4
    for (int n = 0; n < nvalid; ++n) { const float v = bf2f(VCb[(size_t)n * 64 + lane]); ocmp[0] += pb[n] * v; ocmp[1] += pb[256 + n] * v; ocmp[2] += pb[512 + n] * v; ocmp[3] += pb[768 + n] * v; }
    const int cur = t >> 6;
    float imp = 0.f;
#pragma unroll
    for (int r = 0; r < 4; ++r)
#pragma unroll
        for (int k = -1; k <= 3; ++k) { const int n = 4 * lane + k; if (n >= 0 && n < 255) imp += pb[r * 256 + n]; }
    const bool forced = (lane == 0) || (lane == cur) || (lane == cur - 1);
    const float val = forced ? 1e4f : (lane <= cur ? imp : -1.0f);
    int cnt = 0;
#pragma unroll 4
    for (int s2 = 0; s2 < 64; ++s2) { const float v2 = __shfl(val, s2); cnt += (v2 > val || (v2 == val && s2 < lane)) ? 1 : 0; }
    const unsigned long long selmask = __ballot(cnt < 16);
    float oslc[4], owin[4];
#pragma unroll
    for (int br = 0; br < 2; ++br) {
        float mx[4], ls[4], oo[4];
#pragma unroll
        for (int r = 0; r < 4; ++r) { mx[r] = -1e30f; ls[r] = 0.f; oo[r] = 0.f; }
        const int lo = br == 0 ? 0 : max(0, t - 511);
        const int kc = br == 0 ? PC_NKS : PC_NKW, vc = br == 0 ? PC_NVS : PC_NVW;
#pragma unroll 1
        for (int s = lo >> 6; s <= cur; ++s) {
            if (br == 0 && !((selmask >> s) & 1ull)) continue;
            const int kpos = 64 * s + lane; const bool ok = kpos <= t && kpos >= lo;
            const bf16* kr = P + (size_t)(b * SEQ + kpos) * PP + kc + 64 * g;
            float d0 = 0.f, d1 = 0.f, d2 = 0.f, d3 = 0.f;
#pragma unroll 2
            for (int d = 0; d < 64; d += 8) { const v4u kk = *(const v4u*)(kr + d); const unsigned kw[4] = {kk.x, kk.y, kk.z, kk.w};
#pragma unroll
                for (int e = 0; e < 4; ++e) { const float k0 = __uint_as_float(kw[e] << 16), k1 = __uint_as_float(kw[e] & 0xffff0000u); const int dd = d + 2 * e;
                    d0 += qrot[dd] * k0 + qrot[dd + 1] * k1; d1 += qrot[64 + dd] * k0 + qrot[64 + dd + 1] * k1; d2 += qrot[128 + dd] * k0 + qrot[128 + dd + 1] * k1; d3 += qrot[192 + dd] * k0 + qrot[192 + dd + 1] * k1; } }
            float dt[4] = {d0, d1, d2, d3};
#pragma unroll
            for (int r = 0; r < 4; ++r) { const float sv = ok ? dt[r] : -1e30f; const float mn = fmaxf(mx[r], wave_max(sv)); const float al = exp2f(mx[r] - mn); const float p = ok ? exp2f(sv - mn) : 0.f;
                ls[r] = ls[r] * al + wave_sum(p); oo[r] *= al; mx[r] = mn; pb[r * 64 + lane] = p; }
            const bf16* vr = P + (size_t)(b * SEQ + 64 * s) * PP + vc + 64 * g + lane;
#pragma unroll 8
            for (int j = 0; j < 64; ++j) { const float v = bf2f(vr[(size_t)j * PP]); oo[0] += pb[j] * v; oo[1] += pb[64 + j] * v; oo[2] += pb[128 + j] * v; oo[3] += pb[192 + j] * v; }
        }
#pragma unroll
        for (int r = 0; r < 4; ++r) { const float o = oo[r] / ls[r]; if (br == 0) oslc[r] = o; else owin[r] = o; }
    }
    bf16* MIX = (bf16*)(F.ws + WS_MIX);
#pragma unroll
    for (int r = 0; r < 4; ++r) { const int hq = 4 * g + r; const float* gb = I.nsa_gate_bias + (size_t)l * 24 + 3 * hq; const bf16* gl = P + (size_t)row * PP + PC_NGATE + 3 * hq;
        const float g0 = sigmoid1(bf2f(gl[0]) + gb[0]), g1 = sigmoid1(bf2f(gl[1]) + gb[1]), g2 = sigmoid1(bf2f(gl[2]) + gb[2]);
        MIX[(size_t)row * D + 256 + 64 * hq + lane] = f2b(g0 * ocmp[r] + g1 * oslc[r] + g2 * owin[r]); }
}

struct Args { Ptrs I; float* out; unsigned char* ws; int l_lo, l_hi, ph_lo, ph_hi, do_pro, do_fin; };
constexpr int NPH = 12;

#define GRID_BAR() do { if (ONE_LAUNCH) xcd_barrier(bar); } while (0)
#define IN(k) (lo <= (k) && (k) < hi)
template <int l>
__device__ __forceinline__ void layer_phases(Frame& F, const Args& args, const XcdBarrier& bar) {
    const int lo = args.ph_lo, hi = args.ph_hi;

        bf16* H = (bf16*)(F.ws + WS_H); bf16* MIX = (bf16*)(F.ws + WS_MIX); bf16* ACT = (bf16*)(F.ws + WS_P); bf16* PJ = (bf16*)(F.ws + WS_P);
        const float* mod = (const float*)(F.ws + WS_MOD); const float* rot = (const float*)(F.ws + WS_ROT);
        const float* modl = mod + (size_t)l * NB * (NADA * D);
        unsigned char* wl = F.ws + WS_W + (size_t)l * W_LAYER;
        const Ptrs& I = *(const Ptrs*)(F.ws + WS_PTRS);
        float* xout = args.out;
        const float* xcur = (l == 0) ? I.x : xout;
        if (IN(0)) { p_norm(F, xcur, I.norm_g + (size_t)(l * 3 + 0) * D, modl, 0, H); GRID_BAR(); }
        if (IN(1)) { pg8::Gemm g{H, (const bf16*)(wl + WO_F1IN), M, 2 * FF, D}; pg8::StaticOrder S; S.init(M, 2 * FF, F.G, (int)blockIdx.x);
            pg8::EpiSwiglu E{ACT, FF}; pg8::gemm_phase<pg8::EpiSwiglu, pg8::StaticOrder, true, true>(F.lds + RING_OFF, g, S, E); GRID_BAR(); }
        if (IN(2)) { pg8::Gemm g{ACT, (const bf16*)(wl + WO_F1OUT), M, D, FF}; pg8::StaticOrder S; S.init(M, D, F.G, (int)blockIdx.x);
            pg8::EpiResid E{xcur, xout, modl + 2 * D, NADA * D, 0.5f}; pg8::gemm_phase<pg8::EpiResid, pg8::StaticOrder, true, true>(F.lds + RING_OFF, g, S, E); GRID_BAR(); }
        if (IN(3)) { p_norm(F, xout, I.norm_g + (size_t)(l * 3 + 1) * D, modl, 1, H); GRID_BAR(); }
        if (IN(4)) { pg8::Gemm g{H, (const bf16*)(wl + WO_WIN), M, NPROJ, D}; pg8::StaticOrder S; S.init(M, NPROJ, F.G, (int)blockIdx.x);
            pg8::EpiProj E{PJ, rot}; pg8::gemm_phase<pg8::EpiProj, pg8::StaticOrder, true, true>(F.lds + RING_OFF, g, S, E); GRID_BAR(); }
        if (IN(5)) {
            for (int u = (int)blockIdx.x; u < 1024 + 1024 + 512; u += F.G) {
                if (u < 1024) gla_unit_naive<false>(F, I, l, u); else if (u < 2048) ret_unit_naive<false>(F, I, l, u - 1024); else cmp_unit_naive(F, I, l, u - 2048); }
            GRID_BAR(); }
        if (IN(6)) { p_scan(F); GRID_BAR(); }
        if (IN(7)) {
            for (int u = (int)blockIdx.x; u < 2048; u += F.G) { if (u < 1024) gla_unit_naive<true>(F, I, l, u); else ret_unit_naive<true>(F, I, l, u - 1024); }
            { LAS float* wl2 = (LAS float*)(F.lds + RING_OFF) + F.wave * 1536; const int gw = (int)blockIdx.x * NWAVES + F.wave, NGW = F.G * NWAVES;
              for (int u = gw; u < NB * 2 * SEQ; u += NGW) { const int t = u & 4095, bg = u >> 12; nsa_unit_naive(F, I, l, bg >> 1, bg & 1, t, wl2); } }
            GRID_BAR(); }
        if (IN(8)) { pg8::Gemm g{MIX, (const bf16*)(wl + WO_WOUT), M, D, D}; pg8::StaticOrder S; S.init(M, D, F.G, (int)blockIdx.x);
            pg8::EpiResid E{xout, xout, modl + 5 * D, NADA * D, 1.0f}; pg8::gemm_phase<pg8::EpiResid, pg8::StaticOrder, true, true>(F.lds + RING_OFF, g, S, E); GRID_BAR(); }
        if (IN(9)) { p_norm(F, xout, I.norm_g + (size_t)(l * 3 + 2) * D, modl, 2, H); GRID_BAR(); }
        if (IN(10)) { pg8::Gemm g{H, (const bf16*)(wl + WO_F2IN), M, 2 * FF, D}; pg8::StaticOrder S; S.init(M, 2 * FF, F.G, (int)blockIdx.x);
            pg8::EpiSwiglu E{ACT, FF}; pg8::gemm_phase<pg8::EpiSwiglu, pg8::StaticOrder, true, true>(F.lds + RING_OFF, g, S, E); GRID_BAR(); }
        if (IN(11)) { pg8::Gemm g{ACT, (const bf16*)(wl + WO_F2OUT), M, D, FF}; pg8::StaticOrder S; S.init(M, D, F.G, (int)blockIdx.x);
            pg8::EpiResid E{xout, xout, modl + 8 * D, NADA * D, 0.5f}; pg8::gemm_phase<pg8::EpiResid, pg8::StaticOrder, true, true>(F.lds + RING_OFF, g, S, E); GRID_BAR(); }

}
#undef IN
__global__ void __launch_bounds__(NWAVES * 64, 2) mk_fwd(Args args) {
    extern __shared__ __attribute__((aligned(16))) unsigned char lds[];
    Frame F;
    F.lds = (LAS unsigned char*)lds;
    F.MISC = (volatile LAS unsigned*)(F.lds + MISC_OFF);
    F.tid = threadIdx.x; F.lane = F.tid & 63; F.wave = __builtin_amdgcn_readfirstlane(F.tid >> 6);
    F.G = gridDim.x; { const int bx = blockIdx.x; F.vcu = (F.G % 8 == 0) ? (bx % 8) * (F.G / 8) + bx / 8 : bx; }
    F.ws = args.ws; F.in = nullptr;
    F.ctl = (gu32*)(args.ws + WS_CTL);
    for (int u = F.tid; u < (LDS_BYTES - LDSCTL_OFF) / 4; u += NWAVES * 64) ((LAS unsigned*)(F.lds + LDSCTL_OFF))[u] = 0u;
    __syncthreads();
    XcdBarrier bar; bar.bar = (unsigned*)(F.ctl + 4096); bar.x = 0; bar.st = nullptr;
    if (ONE_LAUNCH) bar = xcd_barrier_post((unsigned*)(F.ctl + 4096), F.MISC + 8);
#define GRID_BAR() do { if (ONE_LAUNCH) xcd_barrier(bar); } while (0)


    if (args.do_pro) {
        if (blockIdx.x == 0 && F.tid == 0) { const float** tb = (const float**)(args.ws + WS_PTRS); const float* const* src = (const float* const*)&args.I;
#pragma unroll
            for (int i = 0; i < 23; ++i) tb[i] = src[i]; }
        p_prologue(F, args.I); GRID_BAR(); }

    if (0 >= args.l_lo && 0 < args.l_hi) layer_phases<0>(F, args, bar);
    if (1 >= args.l_lo && 1 < args.l_hi) layer_phases<1>(F, args, bar);
    if (2 >= args.l_lo && 2 < args.l_hi) layer_phases<2>(F, args, bar);
    if (3 >= args.l_lo && 3 < args.l_hi) layer_phases<3>(F, args, bar);
    if (args.do_fin) { const Ptrs& I = *(const Ptrs*)(args.ws + WS_PTRS); p_final(F, args.out, I.final_norm_g); }
}

extern "C" void kernel_launch(void* const* d_in, const int* in_sizes, int n_in, void* d_out, int out_size, void* d_ws, size_t ws_size, hipStream_t stream) {
    static int grid = 0;
    if (grid == 0) {
        if (n_in != 23 || out_size != M * D || ws_size < WS_END) { fprintf(stderr, "kernel_launch: unexpected shapes: n_in %d out %d ws %zu\n", n_in, out_size, ws_size); grid = -1; return; }
        int dev = 0, cus = 0, per_cu = 0;
        if (hipGetDevice(&dev) != hipSuccess || hipDeviceGetAttribute(&cus, hipDeviceAttributeMultiprocessorCount, dev) != hipSuccess) { grid = -1; return; }
        if (hipFuncSetAttribute((const void*)mk_fwd, hipFuncAttributeMaxDynamicSharedMemorySize, LDS_BYTES) != hipSuccess) { fprintf(stderr, "kernel_launch: hipFuncSetAttribute failed\n"); grid = -1; return; }
        if (hipOccupancyMaxActiveBlocksPerMultiprocessor(&per_cu, (const void*)mk_fwd, NWAVES * 64, LDS_BYTES) != hipSuccess || per_cu < 1) fprintf(stderr, "kernel_launch: occupancy query reports %d\n", per_cu);
        (void)hipGetLastError();
        grid = cus;
    }
    if (grid < 0) return;
    if (hipMemsetAsync((char*)d_ws + WS_CTL, 0, CTL_ZERO_BYTES, stream) != hipSuccess) return;
    Args a{};
    const float** pp = (const float**)&a.I;
    for (int i = 0; i < 23; ++i) pp[i] = (const float*)d_in[i];
    a.out = (float*)d_out; a.ws = (unsigned char*)d_ws;
    if (ONE_LAUNCH) {
        a.l_lo = 0; a.l_hi = NL; a.ph_lo = 0; a.ph_hi = NPH; a.do_pro = 1; a.do_fin = 1;
        hipLaunchKernelGGL(mk_fwd, dim3(grid), dim3(NWAVES * 64), LDS_BYTES, stream, a);
    } else {
        a.l_lo = 0; a.l_hi = 0; a.ph_lo = 0; a.ph_hi = 0; a.do_pro = 1; a.do_fin = 0;
        hipLaunchKernelGGL(mk_fwd, dim3(grid), dim3(NWAVES * 64), LDS_BYTES, stream, a);
        a.do_pro = 0;
        for (int l = 0; l < NL; ++l) for (int p = 0; p < NPH; ++p) { a.l_lo = l; a.l_hi = l + 1; a.ph_lo = p; a.ph_hi = p + 1; hipLaunchKernelGGL(mk_fwd, dim3(grid), dim3(NWAVES * 64), LDS_BYTES, stream, a); }
        a.l_lo = 0; a.l_hi = 0; a.ph_lo = 0; a.ph_hi = 0; a.do_fin = 1;
        hipLaunchKernelGGL(mk_fwd, dim3(grid), dim3(NWAVES * 64), LDS_BYTES, stream, a);
    }
}
```

```cpp
#include <hip/hip_runtime.h>
#include <cstdio>
#include <cstdint>
namespace pg8 {
#define PG8_LAS __attribute__((address_space(3)))
typedef unsigned short bf16_t;
typedef short bf16x8 __attribute__((ext_vector_type(8)));
typedef float f32x4 __attribute__((ext_vector_type(4)));
typedef unsigned u32x4 __attribute__((ext_vector_type(4)));
constexpr int BM = 256, BK = 64, HALF = 128, HTB = HALF * BK * 2  , STAGE_BYTES = 8 * HTB, NXCD = 8, WGM = 8;

__host__ __device__ __forceinline__ int lds_byte(int r, int c) { const int st = (r >> 4) * 2 + (c >> 5), rr = r & 15, cc = c & 31, ob = rr * 64 + cc * 2; return st * 1024 + (ob ^ (((ob >> 9) & 1) << 5)); }
__host__ __device__ __forceinline__ void stage_rc(int b, int& R, int& C) { const int st = b / 1024, sb = b % 1024, swz = sb ^ (((sb >> 9) & 1) << 5); R = (st >> 1) * 16 + swz / 64; C = (st & 1) * 32 + (swz % 64) / 2; }
__host__ __device__ __forceinline__ int perm32(int rho) { const int n = rho >> 4, i = rho & 15; return 8 * (i >> 2) + 4 * n + (i & 3); }

struct Unit { int pm, pn; };
struct Gemm { const bf16_t* A; const bf16_t* Bt; int M, N, K; };

struct StaticOrder {
    int nM, nN, nwg, G, c;
    __host__ __device__ void init(int M, int N, int G_, int c_) { nM = M / BM; nN = N / BM; nwg = nM * nN; G = G_; c = c_; }
    __host__ __device__ bool next(int i, Unit& u) const {
        const long L = (long)i * G + c; if (L >= nwg) return false;
        int wgid = (int)L; { const int q = nwg / NXCD, r = nwg % NXCD, xcd = wgid % NXCD, off = wgid / NXCD; wgid = (xcd < r ? xcd * (q + 1) : r * (q + 1) + (xcd - r) * q) + off; }
        const int nig = WGM * nN, gid = wgid / nig, fm = gid * WGM, gsz = (nM - fm) < WGM ? (nM - fm) : WGM;
        u.pm = fm + ((wgid % nig) % gsz); u.pn = (wgid % nig) / gsz; return true;
    }
    __device__ __forceinline__ void a_ready(const Unit&) const {}
    __device__ __forceinline__ void done(const Unit&) const {}
};

__device__ __forceinline__ unsigned cvt_pk_bf16(float lo, float hi) { unsigned r; asm volatile("v_cvt_pk_bf16_f32 %0, %1, %2" : "=v"(r) : "v"(lo), "v"(hi)); return r; }
__device__ __forceinline__ float silu_f(float x) { return x * __builtin_amdgcn_rcpf(1.0f + __builtin_amdgcn_exp2f(-1.4426950408889634f * x)); }

struct EpiSwiglu {
    static constexpr bool PERM = true, AFTER_DRAIN = false;
    bf16_t* O; int ldc;
    __device__ __forceinline__ void operator()(const f32x4 (&acc)[2][2][4][2], const Unit& u, int wr, int wc, int fr, int fq) const {
        const int row0 = u.pm * BM + wr * 64 + fr; const int col0 = u.pn * HALF + wc * 32 + 8 * fq;
#pragma unroll
        for (int ai = 0; ai < 2; ++ai)
#pragma unroll
            for (int m = 0; m < 4; ++m) { bf16_t* rowp = O + (size_t)(row0 + ai * HALF + m * 16) * ldc + col0;
                const f32x4 g0 = acc[ai][0][m][0], g1 = acc[ai][0][m][1], u0 = acc[ai][1][m][0], u1 = acc[ai][1][m][1];
                u32x4 w; w.x = cvt_pk_bf16(silu_f(g0[0]) * u0[0], silu_f(g0[1]) * u0[1]); w.y = cvt_pk_bf16(silu_f(g0[2]) * u0[2], silu_f(g0[3]) * u0[3]);
                w.z = cvt_pk_bf16(silu_f(g1[0]) * u1[0], silu_f(g1[1]) * u1[1]); w.w = cvt_pk_bf16(silu_f(g1[2]) * u1[2], silu_f(g1[3]) * u1[3]);
                *(u32x4*)rowp = w; }
    }
};

struct EpiResid {
    static constexpr bool PERM = false, AFTER_DRAIN = false;
    const float* base; float* out; const float* coef; int cstride; float cmul;
    __device__ __forceinline__ void operator()(const f32x4 (&acc)[2][2][4][2], const Unit& u, int wr, int wc, int fr, int fq) const {
        const int col0 = u.pn * BM + wc * 32 + 4 * fq; const float* cf = coef + (size_t)(u.pm >> 4) * cstride + col0;
        f32x4 cv[2][2];
#pragma unroll
        for (int bj = 0; bj < 2; ++bj)
#pragma unroll
            for (int n = 0; n < 2; ++n) cv[bj][n] = *(const f32x4*)(cf + bj * HALF + n * 16) * cmul;
#pragma unroll
        for (int ai = 0; ai < 2; ++ai)
#pragma unroll
            for (int m = 0; m < 4; ++m) { const size_t off = (size_t)(u.pm * BM + ai * HALF + wr * 64 + m * 16 + fr) * 1024 + col0;
#pragma unroll
                for (int bj = 0; bj < 2; ++bj)
#pragma unroll
                    for (int n = 0; n < 2; ++n) { const f32x4 bs = *(const f32x4*)(base + off + bj * HALF + n * 16); *(f32x4*)(out + off + bj * HALF + n * 16) = bs + cv[bj][n] * acc[ai][bj][m][n]; } }
    }
};

struct EpiProj {
    static constexpr bool PERM = true, AFTER_DRAIN = false;
    bf16_t* P; const float* rot;
    __device__ __forceinline__ void operator()(const f32x4 (&acc)[2][2][4][2], const Unit& u, int wr, int wc, int fr, int fq) const {
        const int T = u.pn; int dst, dst2 = -1, rotm = 0; float sc = 1.f;
        switch (T) {
            case 0: dst = 0; sc = 0.125f; break;
            case 1: dst = 256; break; case 2: dst = 512; break; case 3: dst = 768; break;
            case 4: dst = 1536; dst2 = 1024; sc = 0.18033688011112042f; rotm = 15; break;
            case 5: dst = 1792; dst2 = 1280; sc = 0.18033688011112042f; rotm = 15; break;
            case 6: dst = 2048; break;
            case 7: dst = 2304; rotm = 3; break;
            case 8: dst = 2560; rotm = 3; break;
            case 9: dst = 2816; rotm = 15; break;
            case 10: dst = 3072; rotm = 15; sc = 0.125f; break;
            case 11: dst = 3328; break; case 12: dst = 3584; break;
            default: dst = 3840; break;
        }
        const bool dorot = (rotm >> wc) & 1;
        const int decm = (T == 9) ? 1 : (T == 10) ? 2 : 0;
        const float lg2 = __builtin_amdgcn_logf(1.0f - __builtin_amdgcn_exp2f(-5.0f - (float)wc));
        const int row0 = u.pm * BM + wr * 64 + fr;
#pragma unroll
        for (int ai = 0; ai < 2; ++ai)
#pragma unroll
            for (int m = 0; m < 4; ++m) { const int row = row0 + ai * HALF + m * 16; bf16_t* rowp = P + (size_t)row * 4096 + 64 * wc + 8 * fq;
                f32x4 a0 = acc[ai][0][m][0] * sc, a1 = acc[ai][0][m][1] * sc, b0 = acc[ai][1][m][0] * sc, b1 = acc[ai][1][m][1] * sc;
                if (dst2 >= 0) { u32x4 w; w.x = cvt_pk_bf16(a0[0], a0[1]); w.y = cvt_pk_bf16(a0[2], a0[3]); w.z = cvt_pk_bf16(a1[0], a1[1]); w.w = cvt_pk_bf16(a1[2], a1[3]); *(u32x4*)(rowp + dst2) = w;
                    w.x = cvt_pk_bf16(b0[0], b0[1]); w.y = cvt_pk_bf16(b0[2], b0[3]); w.z = cvt_pk_bf16(b1[0], b1[1]); w.w = cvt_pk_bf16(b1[2], b1[3]); *(u32x4*)(rowp + dst2 + 32) = w; }
                if (dorot) { const float* rp = rot + (size_t)(row & 4095) * 64 + 8 * fq; const f32x4 c0 = *(const f32x4*)rp, c1 = *(const f32x4*)(rp + 4), s0 = *(const f32x4*)(rp + 32), s1 = *(const f32x4*)(rp + 36);
                    const f32x4 y0 = a0 * c0 - b0 * s0, y1 = a1 * c1 - b1 * s1, z0 = a0 * s0 + b0 * c0, z1 = a1 * s1 + b1 * c1; a0 = y0; a1 = y1; b0 = z0; b1 = z1; }
                if (decm) { const int ii = row & 63; const float fac = __builtin_amdgcn_exp2f(lg2 * (float)(decm == 1 ? ii + 1 : 63 - ii)); a0 = a0 * fac; a1 = a1 * fac; b0 = b0 * fac; b1 = b1 * fac; }
                u32x4 w; w.x = cvt_pk_bf16(a0[0], a0[1]); w.y = cvt_pk_bf16(a0[2], a0[3]); w.z = cvt_pk_bf16(a1[0], a1[1]); w.w = cvt_pk_bf16(a1[2], a1[3]); *(u32x4*)(rowp + dst) = w;
                w.x = cvt_pk_bf16(b0[0], b0[1]); w.y = cvt_pk_bf16(b0[2], b0[3]); w.z = cvt_pk_bf16(b1[0], b1[1]); w.w = cvt_pk_bf16(b1[2], b1[3]); *(u32x4*)(rowp + dst + 32) = w; }
    }
};

template <class Epi, class Sched, bool ALIGN_EPI = false, bool SP2 = false>
__device__ __forceinline__ void gemm_phase(PG8_LAS unsigned char* lds, const Gemm g, const Sched& S, const Epi& E) {
    int tid_ = threadIdx.x; asm volatile("" : "+v"(tid_));
    const int tid = tid_, wid = __builtin_amdgcn_readfirstlane(tid >> 6), lane = tid & 63, wr = wid >> 2, wc = wid & 3, fr = lane & 15, fq = lane >> 4;
    const int K = g.K, nt = K / BK;
    unsigned voffA[2], voffB[2];
#pragma unroll
    for (int i = 0; i < 2; ++i) { int R, C; stage_rc(tid * 16 + i * 8192, R, C); const int Rb = Epi::PERM ? ((R & ~31) + perm32(R & 31)) : R;
        voffA[i] = (unsigned)(R * K + C) * 2u; voffB[i] = (unsigned)(Rb * K + C) * 2u; }
    const size_t kstep = (size_t)(BK * 2);
    const size_t hstep = (size_t)HALF * K * 2;
    const size_t tstep = 2 * hstep;
    const unsigned ldsw = (unsigned)wid * 1024u;
    const int aoff = lds_byte(wr * 64 + fr, fq * 8), boff = lds_byte(wc * 32 + fr, fq * 8);
#define PG8_SA(b, h) (((b) * 2 + (h)) * HTB)
#define PG8_SB(b, h) ((4 + (b) * 2 + (h)) * HTB)
#define PG8_STAGE(bufoff, gbase, voff) do { _Pragma("unroll") for (int _i = 0; _i < 2; ++_i) \
        __builtin_amdgcn_global_load_lds((const unsigned*)((const char*)(gbase) + (voff)[_i]), (PG8_LAS unsigned*)(lds + (bufoff) + ldsw + _i * 8192), 16, 0, 0); } while (0)
#define PG8_LDA(dst, b, h) do { _Pragma("unroll") for (int m = 0; m < 4; ++m) _Pragma("unroll") for (int k = 0; k < 2; ++k) dst[m][k] = *(const PG8_LAS bf16x8*)(lds + PG8_SA(b, h) + aoff + m * 2048 + k * 1024); } while (0)
#define PG8_LDB(dst, b, h) do { _Pragma("unroll") for (int n = 0; n < 2; ++n) _Pragma("unroll") for (int k = 0; k < 2; ++k) dst[n][k] = *(const PG8_LAS bf16x8*)(lds + PG8_SB(b, h) + boff + n * 2048 + k * 1024); } while (0)
#define PG8_MMA(ai, bj, At, Bt) do { __builtin_amdgcn_s_setprio(1); _Pragma("unroll") for (int m = 0; m < 4; ++m) _Pragma("unroll") for (int n = 0; n < 2; ++n) _Pragma("unroll") for (int k = 0; k < 2; ++k) \
        acc[ai][bj][m][n] = __builtin_amdgcn_mfma_f32_16x16x32_bf16(Bt[n][k], At[m][k], acc[ai][bj][m][n], 0, 0, 0); __builtin_amdgcn_s_setprio(0); } while (0)
#define PG8_WAIT_V(n) asm volatile("s_waitcnt vmcnt(" #n ")" ::: "memory")
#define PG8_WAIT_L(n) asm volatile("s_waitcnt lgkmcnt(" #n ")" ::: "memory")
#define PG8_BAR __builtin_amdgcn_s_barrier()
#define PG8_SCHED __builtin_amdgcn_sched_barrier(0)
    Unit cur, nxt; int ui = 0;
    if (!S.next(0, cur)) return;
    f32x4 acc[2][2][4][2];
#pragma unroll
    for (int a = 0; a < 2; ++a)
#pragma unroll
        for (int b = 0; b < 2; ++b)
#pragma unroll
            for (int m = 0; m < 4; ++m)
#pragma unroll
                for (int n = 0; n < 2; ++n) acc[a][b][m][n] = (f32x4){0.f, 0.f, 0.f, 0.f};
    bf16x8 At[4][2], B0[2][2], B1[2][2];
    const char* cA = (const char*)g.A + (size_t)cur.pm * tstep; const char* cB = (const char*)g.Bt + (size_t)cur.pn * tstep;
    S.a_ready(cur);
    if constexpr (SP2) {
        PG8_STAGE(PG8_SB(0, 0), cB, voffB); PG8_STAGE(PG8_SB(0, 1), cB + hstep, voffB); PG8_STAGE(PG8_SA(0, 0), cA, voffA); PG8_STAGE(PG8_SA(0, 1), cA + hstep, voffA);
        if (wr == 1) PG8_BAR;
        PG8_WAIT_V(2); PG8_BAR;
        PG8_STAGE(PG8_SB(1, 0), cB + kstep, voffB); PG8_STAGE(PG8_SA(1, 0), cA + kstep, voffA); PG8_STAGE(PG8_SB(1, 1), cB + hstep + kstep, voffB);
        PG8_WAIT_V(6); PG8_BAR;
    } else {
        PG8_STAGE(PG8_SB(0, 0), cB, voffB); PG8_STAGE(PG8_SA(0, 0), cA, voffA); PG8_STAGE(PG8_SB(0, 1), cB + hstep, voffB); PG8_STAGE(PG8_SA(0, 1), cA + hstep, voffA);
        if (wr == 1) PG8_BAR;
        PG8_WAIT_V(4); PG8_BAR;
        PG8_STAGE(PG8_SB(1, 0), cB + kstep, voffB); PG8_STAGE(PG8_SA(1, 0), cA + kstep, voffA); PG8_STAGE(PG8_SB(1, 1), cB + hstep + kstep, voffB);
        PG8_WAIT_V(6); PG8_BAR;
    }
    for (;;) {
        const bool has_next = S.next(ui + 1, nxt);
        const char* nA = has_next ? (const char*)g.A + (size_t)nxt.pm * tstep : cA; const char* nB = has_next ? (const char*)g.Bt + (size_t)nxt.pn * tstep : cB;
        for (int t = 0; t < nt; t += 2) {
            const bool last = (t == nt - 2);
            const char* a1 = cA + (size_t)(t + 1) * kstep;
            const char* a2 = last ? nA : cA + (size_t)(t + 2) * kstep; const char* b2 = last ? nB : cB + (size_t)(t + 2) * kstep;
            const char* a3 = a2 + kstep; const char* b3 = b2 + kstep;
            if (last && has_next) S.a_ready(nxt);
            if constexpr (SP2) {
            PG8_LDB(B0, 0, 0); PG8_LDB(B1, 0, 1); PG8_SCHED; PG8_LDA(At, 0, 0); PG8_STAGE(PG8_SA(1, 1), a1 + hstep, voffA);
            PG8_WAIT_V(8); PG8_WAIT_L(0); PG8_BAR; PG8_MMA(0, 0, At, B0); PG8_MMA(0, 1, At, B1); PG8_BAR; PG8_SCHED;
            PG8_LDA(At, 0, 1); PG8_STAGE(PG8_SB(0, 0), b2, voffB); PG8_STAGE(PG8_SB(0, 1), b2 + hstep, voffB); PG8_STAGE(PG8_SA(0, 0), a2, voffA);
            PG8_WAIT_V(8); PG8_WAIT_L(0); PG8_BAR; PG8_MMA(1, 0, At, B0); PG8_MMA(1, 1, At, B1); PG8_BAR; PG8_SCHED;
            PG8_LDB(B0, 1, 0); PG8_LDB(B1, 1, 1); PG8_SCHED; PG8_LDA(At, 1, 0); PG8_STAGE(PG8_SA(0, 1), a2 + hstep, voffA);
            PG8_WAIT_V(8); PG8_WAIT_L(0); PG8_BAR; PG8_MMA(0, 0, At, B0); PG8_MMA(0, 1, At, B1); PG8_BAR; PG8_SCHED;
            PG8_LDA(At, 1, 1); PG8_STAGE(PG8_SB(1, 0), b3, voffB); PG8_STAGE(PG8_SB(1, 1), b3 + hstep, voffB); PG8_STAGE(PG8_SA(1, 0), a3, voffA);
            PG8_WAIT_V(8); PG8_WAIT_L(0); PG8_BAR; PG8_MMA(1, 0, At, B0); PG8_MMA(1, 1, At, B1); PG8_BAR; PG8_SCHED;
            } else {
            PG8_LDB(B0, 0, 0); PG8_SCHED; PG8_LDA(At, 0, 0); PG8_STAGE(PG8_SA(1, 1), a1 + hstep, voffA);
            PG8_WAIT_L(8); PG8_BAR; PG8_WAIT_L(0); PG8_MMA(0, 0, At, B0); PG8_BAR; PG8_SCHED;
            PG8_LDB(B1, 0, 1); PG8_STAGE(PG8_SB(0, 0), b2, voffB);
            PG8_BAR; PG8_WAIT_L(0); PG8_MMA(0, 1, At, B1); PG8_BAR;
            PG8_LDA(At, 0, 1); PG8_STAGE(PG8_SA(0, 0), a2, voffA);
            PG8_BAR; PG8_WAIT_L(0); PG8_MMA(1, 0, At, B0); PG8_BAR; PG8_SCHED;
            PG8_STAGE(PG8_SB(0, 1), b2 + hstep, voffB);
            PG8_WAIT_V(6); PG8_BAR; PG8_MMA(1, 1, At, B1); PG8_BAR;
            PG8_LDB(B0, 1, 0); PG8_SCHED; PG8_LDA(At, 1, 0); PG8_STAGE(PG8_SA(0, 1), a2 + hstep, voffA);
            PG8_WAIT_L(8); PG8_BAR; PG8_WAIT_L(0); PG8_MMA(0, 0, At, B0); PG8_BAR; PG8_SCHED;
            PG8_LDB(B1, 1, 1); PG8_STAGE(PG8_SB(1, 0), b3, voffB);
            PG8_BAR; PG8_WAIT_L(0); PG8_MMA(0, 1, At, B1); PG8_BAR;
            PG8_LDA(At, 1, 1); PG8_STAGE(PG8_SA(1, 0), a3, voffA);
            PG8_BAR; PG8_WAIT_L(0); PG8_MMA(1, 0, At, B0); PG8_BAR; PG8_SCHED;
            PG8_STAGE(PG8_SB(1, 1), b3 + hstep, voffB);
            PG8_WAIT_V(6); PG8_BAR; PG8_MMA(1, 1, At, B1); PG8_BAR;
            }
        }
        if constexpr (ALIGN_EPI) { if (wr == 0) PG8_BAR; }
        if constexpr (!Epi::AFTER_DRAIN) { E(acc, cur, wr, wc, fr, fq); S.done(cur); }
        if (!has_next) break;
#pragma unroll
        for (int a = 0; a < 2; ++a)
#pragma unroll
            for (int b = 0; b < 2; ++b)
#pragma unroll
                for (int m = 0; m < 4; ++m)
#pragma unroll
                    for (int n = 0; n < 2; ++n) acc[a][b][m][n] = (f32x4){0.f, 0.f, 0.f, 0.f};
        cur = nxt; cA = nA; cB = nB; ++ui;
        if constexpr (ALIGN_EPI) { if (wr == 1) PG8_BAR; }
    }
    PG8_WAIT_V(0);
    if constexpr (!ALIGN_EPI) { if (wr == 0) PG8_BAR; }
    PG8_BAR;
    if constexpr (Epi::AFTER_DRAIN) { E.fused(acc, cur, wr, wc, fr, fq, lds, wid, lane); S.done(cur); }
#undef PG8_SA
#undef PG8_SB
#undef PG8_STAGE
#undef PG8_LDA
#undef PG8_LDB
#undef PG8_MMA
#undef PG8_WAIT_V
#undef PG8_WAIT_L
#undef PG8_BAR
#undef PG8_SCHED
}
}

constexpr int NWAVES = 8;
#ifndef MK_ONE_LAUNCH
#define MK_ONE_LAUNCH 1
#endif
constexpr bool ONE_LAUNCH = MK_ONE_LAUNCH != 0;
#ifndef MK_MIX_NAIVE
#define MK_MIX_NAIVE 0
#endif
#ifndef MK_TPROBE
#define MK_TPROBE 0
#endif
#ifndef MK_NPROBE
#define MK_NPROBE 0
#endif
#ifndef MK_NSA_FAST
#define MK_NSA_FAST 1
#endif
#ifndef MK_REP
#define MK_REP 0
#endif
#ifndef MK_CHECK
#define MK_CHECK 0
#endif
#ifndef MK_CHK_LO
#define MK_CHK_LO 256
#define MK_CHK_HI 768
#endif
constexpr int CW_CHK = 2048;
#ifndef MK_NSA_NAIVE
#define MK_NSA_NAIVE 0
#endif

constexpr int NB = 4, SEQ = 4096, D = 1024, NL = 4, FF = 2816, INW = 3368, NPROJ = 3584, PP = 4096, NADA = 9;
constexpr int M = NB * SEQ;
constexpr float NORM_EPS = 1e-6f;
constexpr int PC_GQ = 0, PC_GK = 256, PC_GV = 512, PC_GG = 768, PC_NQRAW = 1024, PC_NQROT = 1536, PC_NKC = 2048, PC_NVC = 2176, PC_NKS = 2304, PC_NVS = 2432, PC_NKW = 2560, PC_NVW = 2688,
              PC_RQ = 2816, PC_RK = 3072, PC_RV = 3328, PC_RG = 3584, PC_GLR = 3840, PC_NGATE = 3856;

constexpr size_t MiB = 1u << 20;
constexpr size_t WS_CTL = 0, CTL_ZERO_BYTES = 1 * MiB;
constexpr size_t WS_MOD = 1 * MiB;
constexpr size_t WS_ROT = 2 * MiB;
constexpr size_t WS_KC = 3 * MiB;
constexpr size_t WS_GDEC = 3 * MiB + 512 * 1024;
constexpr size_t WS_PTRS = 3 * MiB + 768 * 1024;
constexpr size_t WS_W = 4 * MiB;
constexpr size_t W_LAYER = 42 * MiB;
constexpr size_t WO_F1IN = 0, WO_F1OUT = (size_t)5632 * 1024 * 2, WO_WIN = WO_F1OUT + (size_t)1024 * 2816 * 2, WO_WOUT = WO_WIN + (size_t)NPROJ * 1024 * 2,
                 WO_F2IN = WO_WOUT + (size_t)1024 * 1024 * 2, WO_F2OUT = WO_F2IN + (size_t)5632 * 1024 * 2;
static_assert(WO_F2OUT + (size_t)1024 * 2816 * 2 == W_LAYER, "weight map");
constexpr size_t WS_H = 172 * MiB;
constexpr size_t WS_MIX = 204 * MiB;
constexpr size_t WS_KVG = 236 * MiB, WS_KVR = 252 * MiB;
constexpr size_t WS_P = 268 * MiB;
constexpr size_t WS_END = 396 * MiB;
constexpr size_t WS_MIX2 = 396 * MiB;
constexpr size_t WS_W1T = 428 * MiB, WS_W2T = 432 * MiB, WS_HBP = 432 * MiB + 512 * 1024, WS_KC2 = 433 * MiB, WS_HP = 434 * MiB;

constexpr int RING_OFF = 0, RING_BYTES = 131072;
constexpr int LDSCTL_OFF = RING_BYTES, MISC_OFF = LDSCTL_OFF + 320;
constexpr int LDS_BYTES = 147456;
static_assert(MISC_OFF + 128 <= LDS_BYTES, "LDS map");

#define GAS __attribute__((address_space(1)))
#define LAS __attribute__((address_space(3)))
typedef unsigned short bf16;
typedef unsigned v4u __attribute__((ext_vector_type(4)));
typedef float f32x4 __attribute__((ext_vector_type(4)));
typedef short bf16x8 __attribute__((ext_vector_type(8)));
typedef GAS unsigned gu32;
typedef GAS unsigned long long gu64;
#define RLX_AGENT __ATOMIC_RELAXED, __HIP_MEMORY_SCOPE_AGENT
#define LDS_WAIT() asm volatile("s_waitcnt lgkmcnt(0)" ::: "memory")
#define VM_WAIT() asm volatile("s_waitcnt vmcnt(0)" ::: "memory")
__device__ __forceinline__ unsigned long long rt() { return __builtin_amdgcn_s_memrealtime(); }
__device__ __forceinline__ unsigned f2bf(float f) { unsigned u = __builtin_bit_cast(unsigned, f); return (u + 0x7fffu + ((u >> 16) & 1u)) >> 16; }
__device__ __forceinline__ unsigned pk2(float lo, float hi) { return f2bf(lo) | (f2bf(hi) << 16); }

#define XB_TMO      128
#define XB_XCNT(j)  (256  + 64 * (j))
#define XB_XSUB(j)  (1280 + 64 * (j))
#define XB_XGEN(j)  (2304 + 64 * (j))
#define XB_TOP      3328
#define XB_TOPGEN   3392
#define XCD_BAR_WORDS 3456
#define XB_SPIN_CAP (1u << 18)

__device__ __forceinline__ unsigned xb_ld(unsigned* p)              { return __hip_atomic_load(p, __ATOMIC_RELAXED, __HIP_MEMORY_SCOPE_AGENT); }
__device__ __forceinline__ unsigned xb_add(unsigned* p, unsigned v) { return __hip_atomic_fetch_add(p, v, __ATOMIC_RELAXED, __HIP_MEMORY_SCOPE_AGENT); }
__device__ __forceinline__ unsigned xb_xcc_id() { return (unsigned)__builtin_amdgcn_s_getreg((3 << 11) | 20) & 0xFu; }
#define XB_SPIN(cond, bar) do { unsigned _sp = 0; while (cond) { __builtin_amdgcn_s_sleep(1); \
    if ((++_sp & 255u) == 0u) { if (xb_ld(&(bar)[XB_TMO])) break; if (_sp > XB_SPIN_CAP) { atomicAdd(&(bar)[XB_TMO], 1u); break; } } } } while (0)

struct XcdBarrier {
    unsigned* bar; unsigned x;
    volatile LAS unsigned* st;
};

__device__ __forceinline__ XcdBarrier xcd_barrier_post(unsigned* bar, volatile LAS unsigned* st) {
    XcdBarrier b; b.bar = bar; b.x = xb_xcc_id(); b.st = st;
    if (threadIdx.x == 0) (void)xb_add(&bar[XB_XCNT(b.x)], 1u);
    return b;
}
__device__ __forceinline__ void xcd_barrier_complete(unsigned* bar, unsigned x, unsigned& nloc, unsigned& nx) {
    const unsigned G = gridDim.x * gridDim.y * gridDim.z;
    unsigned sum, cnt, mine, sp = 0u;
    for (;;) {
        sum = 0u; cnt = 0u; mine = 0u;
#pragma unroll
        for (unsigned j = 0; j < 16; ++j) { const unsigned c = xb_ld(&bar[XB_XCNT(j)]); sum += c; cnt += (c > 0u) ? 1u : 0u; mine = (j == x) ? c : mine; }
        if (sum == G) break;
        __builtin_amdgcn_s_sleep(1);
        if ((++sp & 255u) == 0u) { if (xb_ld(&bar[XB_TMO])) break; if (sp > XB_SPIN_CAP) { atomicAdd(&bar[XB_TMO], 1u); break; } }
    }
    nloc = mine > 0u ? mine : 1u; nx = cnt > 0u ? cnt : 1u;
}

__device__ __forceinline__ void xcd_barrier(const XcdBarrier& b) {
    asm volatile("s_waitcnt vmcnt(0)" ::: "memory");
    __syncthreads();
    if (threadIdx.x == 0) {
        unsigned* bar = b.bar;
        __builtin_amdgcn_s_waitcnt(0);
        unsigned nloc = b.st[0], nx = b.st[1];
        if (nloc == 0u) { xcd_barrier_complete(bar, b.x, nloc, nx); b.st[0] = nloc; b.st[1] = nx; }
        const unsigned old = xb_add(&bar[XB_XSUB(b.x)], 1u);
        const unsigned gen = old / nloc;
        if (old + 1u == (gen + 1u) * nloc) {
            __builtin_amdgcn_fence(__ATOMIC_RELEASE, "agent");
            asm volatile("s_waitcnt vmcnt(0)" ::: "memory");
            const unsigned og = xb_add(&bar[XB_TOP], 1u);
            const unsigned tg = og / nx;
            if (og + 1u == (tg + 1u) * nx) xb_add(&bar[XB_TOPGEN], 1u);
            else XB_SPIN(xb_ld(&bar[XB_TOPGEN]) == tg, bar);
            __builtin_amdgcn_fence(__ATOMIC_ACQUIRE, "agent");
            xb_add(&bar[XB_XGEN(b.x)], 1u);
            asm volatile("s_waitcnt vmcnt(0)" ::: "memory");
        } else {
            XB_SPIN(xb_ld(&bar[XB_XGEN(b.x)]) == gen, bar);
            __builtin_amdgcn_fence(__ATOMIC_ACQUIRE, "agent");
            asm volatile("s_waitcnt vmcnt(0)" ::: "memory");
        }
    }
    __syncthreads();
}

struct Frame {
    LAS unsigned char* lds;
    volatile LAS unsigned* MISC;
    gu32* ctl;
    int tid, lane, wave;
    int vcu, G;
    const float* const* in;
    unsigned char* ws;
};
__device__ __forceinline__ float bf2f(bf16 u) { return __uint_as_float((unsigned)u << 16); }
__device__ __forceinline__ bf16 f2b(float f) { return (bf16)f2bf(f); }
__device__ __forceinline__ float wave_sum(float v) {
#pragma unroll
    for (int o = 1; o < 64; o <<= 1) v += __shfl_xor(v, o);
    return v;
}
__device__ __forceinline__ float wave_max(float v) {
#pragma unroll
    for (int o = 1; o < 64; o <<= 1) v = fmaxf(v, __shfl_xor(v, o));
    return v;
}
__device__ __forceinline__ float silu1(float x) { return x / (1.0f + __expf(-x)); }
__device__ __forceinline__ float sigmoid1(float x) { return 1.0f / (1.0f + __expf(-x)); }

template <class Map>
__device__ __forceinline__ void p0_transpose_item(const float* W, int K, int N, bf16* WT, int NT, LAS float* scr, int item, int lane, Map srcmap) {
    const int nblk = NT / 32, kb = item / nblk, nb = item % nblk, k0 = 64 * kb, n0 = 32 * nb;
    const int kq = lane >> 3, c4 = (lane & 7) * 4; const int sc = srcmap(n0 + c4);
    f32x4 v[8];
#pragma unroll
    for (int i = 0; i < 8; ++i) v[i] = sc >= 0 ? *(const GAS f32x4*)(W + (size_t)(k0 + kq + 8 * i) * N + sc) : (f32x4){0.f, 0.f, 0.f, 0.f};
#pragma unroll
    for (int i = 0; i < 8; ++i) { LAS float* d = scr + (kq + 8 * i) * 33 + c4; d[0] = v[i].x; d[1] = v[i].y; d[2] = v[i].z; d[3] = v[i].w; }
    LDS_WAIT(); asm volatile("" ::: "memory");
    const int c = lane & 7;
#pragma unroll
    for (int j = 0; j < 4; ++j) { const int n = (lane >> 3) + 8 * j; const LAS float* s = scr + (8 * c) * 33 + n;
        v4u o; o.x = pk2(s[0 * 33], s[1 * 33]); o.y = pk2(s[2 * 33], s[3 * 33]); o.z = pk2(s[4 * 33], s[5 * 33]); o.w = pk2(s[6 * 33], s[7 * 33]);
        *(GAS v4u*)(WT + (size_t)(n0 + n) * K + k0 + 8 * c) = o; }
    LDS_WAIT(); asm volatile("" ::: "memory");
}
struct MapId { __device__ __forceinline__ int operator()(int n) const { return n; } };
struct MapFfnIn { __device__ __forceinline__ int operator()(int n) const { const int t = n >> 8, c = n & 255; return (c >> 7) * FF + 128 * t + (c & 127); } };
struct MapWin { __device__ __forceinline__ int operator()(int n) const {
    const int T = n >> 8, c = n & 255, o = 64 * ((c & 127) >> 5) + 32 * (c >> 7) + (c & 31);
    switch (T) { case 0: return o; case 1: return 256 + o; case 2: return 512 + o; case 3: return 768 + o; case 4: return 1040 + o; case 5: return 1296 + o; case 6: return 1552 + o; case 7: return 1808 + o;
                 case 8: return 2064 + o; case 9: return 2344 + o; case 10: return 2600 + o; case 11: return 2856 + o; case 12: return 3112 + o;
                 default: return o < 16 ? 1024 + o : (o < 40 ? 2320 + (o - 16) : -1); } } };

__device__ const double INV_FREQ[32] = {1.0,0.7498942093324559,0.5623413251903491,0.4216965034285822,0.31622776601683794,0.23713737056616552,0.1778279410038923,0.1333521432163324,0.1,0.07498942093324558,0.05623413251903491,0.042169650342858224,0.03162277660168379,0.023713737056616554,0.01778279410038923,0.01333521432163324,0.01,0.007498942093324558,0.005623413251903491,0.004216965034285823,0.0031622776601683794,0.0023713737056616554,0.0017782794100389228,0.001333521432163324,0.001,0.0007498942093324559,0.0005623413251903491,0.00042169650342858224,0.00031622776601683794,0.00023713737056616554,0.00017782794100389227,0.0001333521432163324};

struct Ptrs {
    const float *x, *c, *w_ada, *b_ada, *norm_g, *ffn1_in, *ffn1_out, *w_in, *gla_a2, *gla_a_bias, *gla_norm_g, *nsa_pe_k, *nsa_pe_v, *nsa_w1_k, *nsa_w2_k, *nsa_w1_v, *nsa_w2_v, *nsa_gate_bias, *ret_norm_g, *w_out, *ffn2_in, *ffn2_out, *final_norm_g;
};

__device__ __forceinline__ void p_prologue(Frame& F, const Ptrs& I) {
    LAS float* scr = (LAS float*)(F.lds + RING_OFF + F.wave * 16384);
    const int gw = F.vcu * NWAVES + F.wave, NGW = F.G * NWAVES;
    constexpr int I_FIN = (D / 64) * (2 * FF / 32), I_FOUT = (FF / 64) * (D / 32), I_WIN = (D / 64) * (NPROJ / 32), I_WOUT = (D / 64) * (D / 32);
    constexpr int I_LAYER = 2 * I_FIN + 2 * I_FOUT + I_WIN + I_WOUT;
    for (int it = gw; it < NL * I_LAYER; it += NGW) {
        const int l = it / I_LAYER; int r = it % I_LAYER;
        unsigned char* wl = F.ws + WS_W + (size_t)l * W_LAYER;
        if (r < I_FIN) { p0_transpose_item(I.ffn1_in + (size_t)l * D * 2 * FF, D, 2 * FF, (bf16*)(wl + WO_F1IN), 2 * FF, scr, r, F.lane, MapFfnIn()); continue; } r -= I_FIN;
        if (r < I_FIN) { p0_transpose_item(I.ffn2_in + (size_t)l * D * 2 * FF, D, 2 * FF, (bf16*)(wl + WO_F2IN), 2 * FF, scr, r, F.lane, MapFfnIn()); continue; } r -= I_FIN;
        if (r < I_FOUT) { p0_transpose_item(I.ffn1_out + (size_t)l * FF * D, FF, D, (bf16*)(wl + WO_F1OUT), D, scr, r, F.lane, MapId()); continue; } r -= I_FOUT;
        if (r < I_FOUT) { p0_transpose_item(I.ffn2_out + (size_t)l * FF * D, FF, D, (bf16*)(wl + WO_F2OUT), D, scr, r, F.lane, MapId()); continue; } r -= I_FOUT;
        if (r < I_WIN) { p0_transpose_item(I.w_in + (size_t)l * D * INW, D, INW, (bf16*)(wl + WO_WIN), NPROJ, scr, r, F.lane, MapWin()); continue; } r -= I_WIN;
        p0_transpose_item(I.w_out + (size_t)l * D * D, D, D, (bf16*)(wl + WO_WOUT), D, scr, r, F.lane, MapId());
    }
    for (int it = gw; it < NL * 2 * (128 + 4 + 16); it += NGW) {
        const int lw = it / 148, r = it % 148, l = lw >> 1, which = lw & 1;
        const float* w1 = (which ? I.nsa_w1_v : I.nsa_w1_k) + (size_t)l * 2048 * 128; const float* w2 = (which ? I.nsa_w2_v : I.nsa_w2_k) + (size_t)l * 128 * 64; const float* pe = (which ? I.nsa_pe_v : I.nsa_pe_k) + (size_t)l * 2048;
        if (r < 128) p0_transpose_item(w1, 2048, 128, (bf16*)(F.ws + WS_W1T) + (size_t)lw * 128 * 2048, 128, scr, r, F.lane, MapId());
        else if (r < 132) p0_transpose_item(w2, 128, 64, (bf16*)(F.ws + WS_W2T) + (size_t)lw * 64 * 128, 64, scr, r - 128, F.lane, MapId());
        else { const int s = r - 132; float a0 = 0.f, a1 = 0.f;
            for (int i = 128 * s; i < 128 * s + 128; ++i) { const float p = pe[i]; a0 += p * w1[(size_t)i * 128 + F.lane]; a1 += p * w1[(size_t)i * 128 + 64 + F.lane]; }
            float* hb = (float*)(F.ws + WS_HBP) + (size_t)lw * 16 * 128 + s * 128; hb[F.lane] = a0; hb[64 + F.lane] = a1; }
    }
    __syncthreads();
    {
        float* rot = (float*)(F.ws + WS_ROT);
        for (int e = (int)blockIdx.x * 512 + F.tid; e < 4096 * 32; e += F.G * 512) {
            const int t = e >> 5, d = e & 31;
            const double a = (double)t * INV_FREQ[d];
            const double kq = __builtin_rint(a * 0.63661977236758134308);
            const double r = (a - kq * 1.57079632679489655800e+00) - kq * 6.12323399573676603587e-17;
            const double r2 = r * r;
            const double sn = r * (1.0 + r2 * (-1.0 / 6 + r2 * (1.0 / 120 + r2 * (-1.0 / 5040 + r2 * (1.0 / 362880 + r2 * (-1.0 / 39916800 + r2 * (1.0 / 6227020800.0)))))));
            const double cs = 1.0 + r2 * (-0.5 + r2 * (1.0 / 24 + r2 * (-1.0 / 720 + r2 * (1.0 / 40320 + r2 * (-1.0 / 3628800 + r2 * (1.0 / 479001600.0 + r2 * (-1.0 / 87178291200.0)))))));
            const int q = ((int)kq) & 3;
            const double c = (q == 0) ? cs : (q == 1) ? -sn : (q == 2) ? -cs : sn;
            const double s = (q == 0) ? sn : (q == 1) ? cs : (q == 2) ? -sn : -cs;
            rot[t * 64 + d] = (float)c; rot[t * 64 + 32 + d] = (float)s;
        }
    }
    {
        LAS float* ca = (LAS float*)(F.lds + RING_OFF);
        LAS float* part = ca + 4096;
        for (int e = F.tid; e < 4096; e += 512) ca[e] = silu1(I.c[e]);
        __syncthreads();
        float* mod = (float*)(F.ws + WS_MOD);
        constexpr int NJG = NADA * D / 64;
        for (int it = (int)blockIdx.x; it < NL * NJG; it += F.G) {
            const int l = it / NJG, jg = it % NJG, j = jg * 64 + F.lane;
            const float* wp = I.w_ada + (size_t)l * D * (NADA * D) + (size_t)(128 * F.wave) * (NADA * D) + j;
            float a0 = 0.f, a1 = 0.f, a2 = 0.f, a3 = 0.f;
#pragma unroll 16
            for (int k = 0; k < 128; ++k) { const float w = wp[(size_t)k * (NADA * D)]; const int kk = 128 * F.wave + k;
                a0 += ca[kk] * w; a1 += ca[1024 + kk] * w; a2 += ca[2048 + kk] * w; a3 += ca[3072 + kk] * w; }
            part[(F.wave * 4 + 0) * 64 + F.lane] = a0; part[(F.wave * 4 + 1) * 64 + F.lane] = a1; part[(F.wave * 4 + 2) * 64 + F.lane] = a2; part[(F.wave * 4 + 3) * 64 + F.lane] = a3;
            __syncthreads();
            if (F.tid < 256) { const int b = F.tid >> 6, ln = F.tid & 63; float s = I.b_ada[(size_t)l * NADA * D + jg * 64 + ln];
#pragma unroll
                for (int w = 0; w < 8; ++w) s += part[(w * 4 + b) * 64 + ln];
                mod[((size_t)l * NB + b) * (NADA * D) + jg * 64 + ln] = s; }
            __syncthreads();
        }
    }
}

__device__ __forceinline__ void p_norm(Frame& F, const float* x, const float* g, const float* modl  , int sub, bf16* H) {
    const int gw = F.vcu * NWAVES + F.wave, NGW = F.G * NWAVES;
    f32x4 gv[4];
#pragma unroll
    for (int j = 0; j < 4; ++j) gv[j] = *(const f32x4*)(g + 4 * F.lane + 256 * j);
    for (int m = gw; m < M; m += NGW) {
        const int b = m >> 12;
        const float* sh = modl + (size_t)b * (NADA * D) + (3 * sub) * D; const float* sc = sh + D;
        const GAS f32x4* xr = (const GAS f32x4*)(x + (size_t)m * D) + F.lane;
        f32x4 v[4]; float s = 0.f;
#pragma unroll
        for (int j = 0; j < 4; ++j) { v[j] = xr[64 * j]; s += (v[j].x * v[j].x + v[j].y * v[j].y) + (v[j].z * v[j].z + v[j].w * v[j].w); }
        const float rstd = 1.f / sqrtf(wave_sum(s) * (1.f / D) + NORM_EPS);
        GAS unsigned long long* o8 = (GAS unsigned long long*)(H + (size_t)m * D) + F.lane;
#pragma unroll
        for (int j = 0; j < 4; ++j) { const f32x4 scv = *(const f32x4*)(sc + 4 * F.lane + 256 * j), shv = *(const f32x4*)(sh + 4 * F.lane + 256 * j);
            const f32x4 y = v[j] * rstd * gv[j] * (scv + 1.0f) + shv;
            o8[64 * j] = (unsigned long long)pk2(y.x, y.y) | ((unsigned long long)pk2(y.z, y.w) << 32); }
    }
}
__device__ __forceinline__ void p_final(Frame& F, float* x, const float* g, const float* chk) {
    const int gw = F.vcu * NWAVES + F.wave, NGW = F.G * NWAVES;
    f32x4 gv[4];
#pragma unroll
    for (int j = 0; j < 4; ++j) gv[j] = *(const f32x4*)(g + 4 * F.lane + 256 * j);
    float cf = 1.0f; if (chk) { const float sd = chk[0], sq = chk[1]; cf = 1.0f + 10.0f * sqrtf(sd / fmaxf(sq, 1e-30f)); }
    for (int m = gw; m < M; m += NGW) {
        GAS f32x4* xr = (GAS f32x4*)(x + (size_t)m * D) + F.lane;
        f32x4 v[4]; float s = 0.f;
#pragma unroll
        for (int j = 0; j < 4; ++j) { v[j] = xr[64 * j]; s += (v[j].x * v[j].x + v[j].y * v[j].y) + (v[j].z * v[j].z + v[j].w * v[j].w); }
        const float rstd = 1.f / sqrtf(wave_sum(s) * (1.f / D) + NORM_EPS);
#pragma unroll
        for (int j = 0; j < 4; ++j) xr[64 * j] = v[j] * rstd * gv[j] * cf;
    }
}

constexpr int LP = 65;
template <bool FULL>
__device__ __forceinline__ void gla_unit_naive(Frame& F, const Ptrs& I, int l, int u, bf16* MIX = nullptr) {
    LAS float* Q = (LAS float*)(F.lds + RING_OFF); LAS float* K = Q + 64 * LP; LAS float* V = K + 64 * LP; LAS float* Bc = V + 64 * LP; LAS float* At = Bc + 64 * LP; LAS float* GL = At + 64 * LP;
    const int n = u & 63, h = (u >> 6) & 3, b = u >> 8, row0 = b * SEQ + 64 * n, tid = F.tid;
    const bf16* P = (const bf16*)(F.ws + WS_P);
    float* KVG = (float*)(F.ws + WS_KVG) + (size_t)u * 4096; float* DEC = (float*)(F.ws + WS_GDEC) + u * 64;
    for (int idx = tid; idx < 4096; idx += 512) { const int i = idx >> 6, d = idx & 63; const bf16* pr = P + (size_t)(row0 + i) * PP + 64 * h + d;
        Q[i * LP + d] = bf2f(pr[PC_GQ]); K[i * LP + d] = bf2f(pr[PC_GK]); V[i * LP + d] = bf2f(pr[PC_GV]); }
    for (int idx = tid; idx < 1024; idx += 512) { const int i = idx >> 4, j = idx & 15; GL[i * 16 + j] = bf2f(P[(size_t)(row0 + i) * PP + PC_GLR + j]); }
    __syncthreads();
    const float* a2 = I.gla_a2 + (size_t)l * 16 * 256 + 64 * h; const float* ab = I.gla_a_bias + (size_t)l * 256 + 64 * h;
    for (int idx = tid; idx < 4096; idx += 512) { const int i = idx >> 6, d = idx & 63; float z = ab[d];
#pragma unroll
        for (int j = 0; j < 16; ++j) z += GL[i * 16 + j] * a2[j * 256 + d];
        Bc[i * LP + d] = (fminf(z, 0.f) - log1pf(expf(-fabsf(z)))) * (1.0f / 16.0f); }
    __syncthreads();
    if (tid < 64) { float run = 0.f; for (int i = 0; i < 64; ++i) { run += Bc[i * LP + tid]; Bc[i * LP + tid] = run; } }
    __syncthreads();
    for (int idx = tid; idx < 4096; idx += 512) { const int i = idx >> 6, d = idx & 63; const float bb = Bc[i * LP + d]; Q[i * LP + d] *= expf(bb); K[i * LP + d] *= expf(-bb); }
    __syncthreads();
    if constexpr (!FULL) {
        for (int idx = tid; idx < 4096; idx += 512) { const int d = idx >> 6, v = idx & 63; float s = 0.f;
            for (int j = 0; j < 64; ++j) s += K[j * LP + d] * V[j * LP + v];
            KVG[v * 64 + d] = expf(Bc[63 * LP + d]) * s; }
        if (tid < 64) DEC[tid] = expf(Bc[63 * LP + tid]);
    } else {
        for (int idx = tid; idx < 4096; idx += 512) { const int i = idx >> 6, j = idx & 63; float s = 0.f;
            if (j <= i) { for (int d = 0; d < 64; ++d) s += Q[i * LP + d] * K[j * LP + d]; }
            At[i * LP + j] = s; }
        __syncthreads();
        const float* gn = I.gla_norm_g + (size_t)l * 64;
        for (int idx = tid; idx < 4096; idx += 512) { const int i = idx >> 6, v = idx & 63; float o = 0.f;
            for (int j = 0; j <= i; ++j) o += At[i * LP + j] * V[j * LP + v];
            for (int d = 0; d < 64; ++d) o += Q[i * LP + d] * KVG[v * 64 + d];
            const float ms = wave_sum(o * o) * (1.0f / 64.0f);
            const float y = o * (1.f / sqrtf(ms + NORM_EPS)) * gn[v];
            const float gg = bf2f(P[(size_t)(row0 + i) * PP + PC_GG + 64 * h + v]);
            MIX[(size_t)(row0 + i) * D + 64 * h + v] = f2b(y * silu1(gg)); }
    }
    __syncthreads();
}
template <bool FULL>
__device__ __forceinline__ void ret_unit_naive(Frame& F, const Ptrs& I, int l, int u, bf16* MIX = nullptr) {
    LAS float* Q = (LAS float*)(F.lds + RING_OFF); LAS float* K = Q + 64 * LP; LAS float* V = K + 64 * LP; LAS float* At = V + 64 * LP;
    const int n = u & 63, h = (u >> 6) & 3, b = u >> 8, row0 = b * SEQ + 64 * n, tid = F.tid;
    const bf16* P = (const bf16*)(F.ws + WS_P);
    float* KVR = (float*)(F.ws + WS_KVR) + (size_t)u * 4096;
    const float lg = log1pf(-exp2f(-5.0f - (float)h));
    for (int idx = tid; idx < 4096; idx += 512) { const int i = idx >> 6, d = idx & 63; const bf16* pr = P + (size_t)(row0 + i) * PP + 64 * h + d;
        Q[i * LP + d] = bf2f(pr[PC_RQ]); K[i * LP + d] = bf2f(pr[PC_RK]); V[i * LP + d] = bf2f(pr[PC_RV]); }
    __syncthreads();
    if constexpr (!FULL) {
        for (int idx = tid; idx < 4096; idx += 512) { const int d = idx >> 6, v = idx & 63; float s = 0.f;
            for (int j = 0; j < 64; ++j) s += K[j * LP + d] * V[j * LP + v];
            KVR[v * 64 + d] = s; }
    } else {
        const float ginv = expf(-64.0f * lg);
        for (int idx = tid; idx < 4096; idx += 512) { const int i = idx >> 6, j = idx & 63; float s = 0.f;
            if (j <= i) { for (int d = 0; d < 64; ++d) s += Q[i * LP + d] * K[j * LP + d]; s *= ginv; }
            At[i * LP + j] = s; }
        __syncthreads();
        const float* gn = I.ret_norm_g + (size_t)l * 64;
        for (int idx = tid; idx < 4096; idx += 512) { const int i = idx >> 6, v = idx & 63; float o = 0.f, o2 = 0.f;
            for (int j = 0; j <= i; ++j) o += At[i * LP + j] * V[j * LP + v];
            for (int d = 0; d < 64; ++d) o2 += Q[i * LP + d] * KVR[v * 64 + d];
            o += o2;
            const float mean = wave_sum(o) * (1.0f / 64.0f); const float xc = o - mean;
            const float var = wave_sum(xc * xc) * (1.0f / 64.0f);
            const float y = xc * (1.f / sqrtf(var + NORM_EPS)) * gn[v];
            const float gg = bf2f(P[(size_t)(row0 + i) * PP + PC_RG + 64 * h + v]);
            MIX[(size_t)(row0 + i) * D + 768 + 64 * h + v] = f2b(y * silu1(gg)); }
    }
    __syncthreads();
}
__device__ __forceinline__ void p_scan(Frame& F, size_t dummy_off = 0) {
    float* KVG = (float*)(F.ws + WS_KVG); float* KVR = (float*)(F.ws + WS_KVR); const float* DEC = (const float*)(F.ws + WS_GDEC);
    for (int e = (int)blockIdx.x * 512 + F.tid; e < 2 * 16 * 4096; e += F.G * 512) {
        const int which = e >> 16, bh = (e >> 12) & 15, dv = e & 4095, d = dv & 63;
        float* base = (which ? KVR : KVG) + (size_t)bh * 64 * 4096 + dv;
        float kv[64], dc[64];
#pragma unroll
        for (int n = 0; n < 64; ++n) kv[n] = base[(size_t)n * 4096];
        if (which == 0) {
#pragma unroll
            for (int n = 0; n < 64; ++n) dc[n] = DEC[(bh * 64 + n) * 64 + d]; }
        else { const float dec = expf(64.0f * log1pf(-exp2f(-5.0f - (float)(bh & 3))));
#pragma unroll
            for (int n = 0; n < 64; ++n) dc[n] = dec; }
        float s = 0.f;
#pragma unroll
        for (int n = 0; n < 64; ++n) { const float k = kv[n]; kv[n] = s; s = s * dc[n] + k; }
#pragma unroll
        for (int n = 0; n < 64; ++n) base[(size_t)n * 4096 + dummy_off] = kv[n];
    }
}
__device__ __forceinline__ void cmp_unit_naive(Frame& F, const Ptrs& I, int l, int u, bf16* KCdst) {
    LAS float* TK = (LAS float*)(F.lds + RING_OFF);
    LAS float* PE = TK + 144 * 64;
    LAS float* HID = PE + 2048;
    const int which = u >> 8, bg = (u >> 5) & 7, ng = u & 31, b = bg >> 1, g = bg & 1, tid = F.tid;
    const bf16* P = (const bf16*)(F.ws + WS_P) + (which ? PC_NVC : PC_NKC) + 64 * g;
    const float* pe = (which ? I.nsa_pe_v : I.nsa_pe_k) + (size_t)l * 2048; const float* w1 = (which ? I.nsa_w1_v : I.nsa_w1_k) + (size_t)l * 2048 * 128; const float* w2 = (which ? I.nsa_w2_v : I.nsa_w2_k) + (size_t)l * 128 * 64;
    bf16* KC = KCdst + (size_t)which * (NB * 2 * 256 * 64) + (size_t)bg * 256 * 64;
    const int t0 = 128 * ng;
    for (int idx = tid; idx < 144 * 64; idx += 512) { const int tt = idx >> 6, d = idx & 63; const int t = t0 + tt; TK[idx] = t < SEQ ? bf2f(P[(size_t)(b * SEQ + t) * PP + d]) : 0.f; }
    for (int idx = tid; idx < 2048; idx += 512) PE[idx] = pe[idx];
    __syncthreads();
    { const int j = tid & 127, rg = tid >> 7; float a0 = 0.f, a1 = 0.f; const LAS float* r0 = TK + (16 * (2 * rg)) * 64; const LAS float* r1 = TK + (16 * (2 * rg + 1)) * 64;
      for (int i = 0; i < 2048; ++i) { const float w = w1[(size_t)i * 128 + j]; const float p = PE[i]; a0 += (r0[i] + p) * w; a1 += (r1[i] + p) * w; }
      HID[(2 * rg) * 128 + j] = silu1(a0); HID[(2 * rg + 1) * 128 + j] = silu1(a1); }
    __syncthreads();
    { const int r = tid >> 6, d = tid & 63; float s = 0.f;
      for (int j = 0; j < 128; ++j) s += HID[r * 128 + j] * w2[j * 64 + d];
      const int n = 8 * ng + r; KC[(size_t)n * 64 + d] = n < 255 ? f2b(s) : (bf16)0; }
    __syncthreads();
}
__device__ __forceinline__ void nsa_unit_naive(Frame& F, const Ptrs& I, int l, int b, int g, int t, LAS float* wl, bf16* MIX) {
    const int lane = F.lane; const int row = b * SEQ + t;
    const bf16* P = (const bf16*)(F.ws + WS_P);
    LAS float* qraw = wl; LAS float* qrot = wl + 256; LAS float* pb = wl + 512;
#pragma unroll
    for (int r = 0; r < 4; ++r) { qraw[r * 64 + lane] = bf2f(P[(size_t)row * PP + PC_NQRAW + 64 * (4 * g + r) + lane]); qrot[r * 64 + lane] = bf2f(P[(size_t)row * PP + PC_NQROT + 64 * (4 * g + r) + lane]); }
    const bf16* KCb = (const bf16*)(F.ws + WS_KC) + (size_t)(b * 2 + g) * 256 * 64; const bf16* VCb = KCb + (size_t)NB * 2 * 256 * 64;
    const int nvalid = (t >= 31) ? min(255, ((t - 31) >> 4) + 1) : 0;
    float sc[4][4];
#pragma unroll
    for (int it = 0; it < 4; ++it) { const int n = it * 64 + lane; float d0 = 0.f, d1 = 0.f, d2 = 0.f, d3 = 0.f;
#pragma unroll 2
        for (int d = 0; d < 64; d += 8) { const v4u kk = *(const v4u*)(KCb + (size_t)n * 64 + d); const unsigned kw[4] = {kk.x, kk.y, kk.z, kk.w};
#pragma unroll
            for (int e = 0; e < 4; ++e) { const float k0 = __uint_as_float(kw[e] << 16), k1 = __uint_as_float(kw[e] & 0xffff0000u); const int dd = d + 2 * e;
                d0 += qraw[dd] * k0 + qraw[dd + 1] * k1; d1 += qraw[64 + dd] * k0 + qraw[64 + dd + 1] * k1; d2 += qraw[128 + dd] * k0 + qraw[128 + dd + 1] * k1; d3 += qraw[192 + dd] * k0 + qraw[192 + dd + 1] * k1; } }
        const bool ok = n < nvalid; sc[it][0] = ok ? d0 : -1e30f; sc[it][1] = ok ? d1 : -1e30f; sc[it][2] = ok ? d2 : -1e30f; sc[it][3] = ok ? d3 : -1e30f; }
    float ocmp[4];
#pragma unroll
    for (int r = 0; r < 4; ++r) { float m = wave_max(fmaxf(fmaxf(sc[0][r], sc[1][r]), fmaxf(sc[2][r], sc[3][r]))); float p[4]; float s = 0.f;
#pragma unroll
        for (int it = 0; it < 4; ++it) { p[it] = (it * 64 + lane < nvalid) ? exp2f(sc[it][r] - m) : 0.f; s += p[it]; }
        s = wave_sum(s); const float inv = s > 0.f ? 1.0f / s : 0.f;
#pragma unroll
        for (int it = 0; it < 4; ++it) pb[r * 256 + it * 64 + lane] = p[it] * inv; }
#pragma unroll
    for (int r = 0; r < 4; ++r) ocmp[r] = 0.f;
#pragma unroll 4
    for (int n = 0; n < nvalid; ++n) { const float v = bf2f(VCb[(size_t)n * 64 + lane]); ocmp[0] += pb[n] * v; ocmp[1] += pb[256 + n] * v; ocmp[2] += pb[512 + n] * v; ocmp[3] += pb[768 + n] * v; }
    const int cur = t >> 6;
    float imp = 0.f;
#pragma unroll
    for (int r = 0; r < 4; ++r)
#pragma unroll
        for (int k = -1; k <= 3; ++k) { const int n = 4 * lane + k; if (n >= 0 && n < 255) imp += pb[r * 256 + n]; }
    const bool forced = (lane == 0) || (lane == cur) || (lane == cur - 1);
    const float val = forced ? 1e4f : (lane <= cur ? imp : -1.0f);
    int cnt = 0;
#pragma unroll 4
    for (int s2 = 0; s2 < 64; ++s2) { const float v2 = __shfl(val, s2); cnt += (v2 > val || (v2 == val && s2 < lane)) ? 1 : 0; }
    const unsigned long long selmask = __ballot(cnt < 16);
    float oslc[4], owin[4];
#pragma unroll
    for (int br = 0; br < 2; ++br) {
        float mx[4], ls[4], oo[4];
#pragma unroll
        for (int r = 0; r < 4; ++r) { mx[r] = -1e30f; ls[r] = 0.f; oo[r] = 0.f; }
        const int lo = br == 0 ? 0 : max(0, t - 511);
        const int kc = br == 0 ? PC_NKS : PC_NKW, vc = br == 0 ? PC_NVS : PC_NVW;
#pragma unroll 1
        for (int s = lo >> 6; s <= cur; ++s) {
            if (br == 0 && !((selmask >> s) & 1ull)) continue;
            const int kpos = 64 * s + lane; const bool ok = kpos <= t && kpos >= lo;
            const bf16* kr = P + (size_t)(b * SEQ + kpos) * PP + kc + 64 * g;
            float d0 = 0.f, d1 = 0.f, d2 = 0.f, d3 = 0.f;
#pragma unroll 2
            for (int d = 0; d < 64; d += 8) { const v4u kk = *(const v4u*)(kr + d); const unsigned kw[4] = {kk.x, kk.y, kk.z, kk.w};
#pragma unroll
                for (int e = 0; e < 4; ++e) { const float k0 = __uint_as_float(kw[e] << 16), k1 = __uint_as_float(kw[e] & 0xffff0000u); const int dd = d + 2 * e;
                    d0 += qrot[dd] * k0 + qrot[dd + 1] * k1; d1 += qrot[64 + dd] * k0 + qrot[64 + dd + 1] * k1; d2 += qrot[128 + dd] * k0 + qrot[128 + dd + 1] * k1; d3 += qrot[192 + dd] * k0 + qrot[192 + dd + 1] * k1; } }
            float dt[4] = {d0, d1, d2, d3};
#pragma unroll
            for (int r = 0; r < 4; ++r) { const float sv = ok ? dt[r] : -1e30f; const float mn = fmaxf(mx[r], wave_max(sv)); const float al = exp2f(mx[r] - mn); const float p = ok ? exp2f(sv - mn) : 0.f;
                ls[r] = ls[r] * al + wave_sum(p); oo[r] *= al; mx[r] = mn; pb[r * 64 + lane] = p; }
            const bf16* vr = P + (size_t)(b * SEQ + 64 * s) * PP + vc + 64 * g + lane;
#pragma unroll 8
            for (int j = 0; j < 64; ++j) { const float v = bf2f(vr[(size_t)j * PP]); oo[0] += pb[j] * v; oo[1] += pb[64 + j] * v; oo[2] += pb[128 + j] * v; oo[3] += pb[192 + j] * v; }
        }
#pragma unroll
        for (int r = 0; r < 4; ++r) { const float o = oo[r] / ls[r]; if (br == 0) oslc[r] = o; else owin[r] = o; }
    }
#pragma unroll
    for (int r = 0; r < 4; ++r) { const int hq = 4 * g + r; const float* gb = I.nsa_gate_bias + (size_t)l * 24 + 3 * hq; const bf16* gl = P + (size_t)row * PP + PC_NGATE + 3 * hq;
        const float g0 = sigmoid1(bf2f(gl[0]) + gb[0]), g1 = sigmoid1(bf2f(gl[1]) + gb[1]), g2 = sigmoid1(bf2f(gl[2]) + gb[2]);
        MIX[(size_t)row * D + 256 + 64 * hq + lane] = f2b(g0 * ocmp[r] + g1 * oslc[r] + g2 * owin[r]); }
}


namespace nsa {
typedef short bf16x8 __attribute__((ext_vector_type(8)));
typedef short s16x4 __attribute__((ext_vector_type(4)));
typedef float f32x16 __attribute__((ext_vector_type(16)));
typedef unsigned u32x4 __attribute__((ext_vector_type(4)));
typedef unsigned u32x2 __attribute__((ext_vector_type(2)));
constexpr int SLOTB = 8192, L_K = 0, L_V = 3 * SLOTB, L_IMP = 6 * SLOTB, IMP_PITCH = 65, L_SEL = L_IMP + 4 * 64 * IMP_PITCH * 4, L_FAC = L_SEL + 512, L_END = L_FAC + 4 * 64 * 4 * 4, STG_PITCH = 136;
static_assert(L_END <= 131072, "nsa LDS map");
#define NSA_WAIT_BAR(N) asm volatile("s_waitcnt vmcnt(" #N ") lgkmcnt(0)\n\ts_barrier" ::: "memory")
__device__ __forceinline__ void glds16(const void* gsrc, unsigned lds_dst) { unsigned keep;
    asm volatile("s_mov_b32 %0, m0\n\ts_mov_b32 m0, %2\n\ts_nop 0\n\tglobal_load_lds_dwordx4 %1, off\n\ts_mov_b32 m0, %0" : "=&s"(keep) : "v"(gsrc), "s"(lds_dst) : "memory"); }
__device__ __forceinline__ void glds16s(const void* sbase, unsigned voff, unsigned lds_dst) { unsigned keep;
    asm volatile("s_mov_b32 %0, m0\n\ts_mov_b32 m0, %2\n\ts_nop 0\n\tglobal_load_lds_dwordx4 %1, %3\n\ts_mov_b32 m0, %0" : "=&s"(keep) : "v"(voff), "s"(lds_dst), "s"(sbase) : "memory"); }
typedef short v4i16_t __attribute__((ext_vector_type(4)));
__device__ __forceinline__ s16x4 vtr(const LAS unsigned char* p) { return __builtin_bit_cast(s16x4, __builtin_amdgcn_ds_read_tr16_b64_v4i16((LAS v4i16_t*)p)); }
__device__ __forceinline__ float partner(float x, int hi) { auto rr = __builtin_amdgcn_permlane32_swap(__float_as_uint(x), __float_as_uint(x), false, false); return __uint_as_float(hi ? rr[0] : rr[1]); }
__device__ __forceinline__ float both_sum(float x) { auto rr = __builtin_amdgcn_permlane32_swap(__float_as_uint(x), __float_as_uint(x), false, false); return __uint_as_float(rr[0]) + __uint_as_float(rr[1]); }
__device__ __forceinline__ float both_max(float x) { auto rr = __builtin_amdgcn_permlane32_swap(__float_as_uint(x), __float_as_uint(x), false, false); return fmaxf(__uint_as_float(rr[0]), __uint_as_float(rr[1])); }
__device__ __forceinline__ unsigned cvtpk(float lo, float hi) { typedef float f2 __attribute__((ext_vector_type(2))); typedef __bf16 b2 __attribute__((ext_vector_type(2))); f2 v = {lo, hi}; b2 b = __builtin_convertvector(v, b2); return __builtin_bit_cast(unsigned, b); }
__device__ __forceinline__ void qkt(f32x16& p0, f32x16& p1, const LAS unsigned char* kb  , const bf16x8 (&qr)[4]) {
    bf16x8 k0[4], k1[4];
#pragma unroll
    for (int d0 = 0; d0 < 4; ++d0) { k0[d0] = *(const LAS bf16x8*)(kb + d0 * 2048); k1[d0] = *(const LAS bf16x8*)(kb + d0 * 2048 + 512); }
    __builtin_amdgcn_sched_barrier(0);
    p0 = f32x16{}; p1 = f32x16{};
#pragma unroll
    for (int d0 = 0; d0 < 4; ++d0) { p0 = __builtin_amdgcn_mfma_f32_32x32x16_bf16(k0[d0], qr[d0], p0, 0, 0, 0); p1 = __builtin_amdgcn_mfma_f32_32x32x16_bf16(k1[d0], qr[d0], p1, 0, 0, 0); }
}
__device__ __forceinline__ void qkt_c(f32x16& p0, f32x16& p1, const LAS unsigned char* kb, const bf16x8 (&qr)[4], const f32x16& ci) {
    { const bf16x8 b0 = *(const LAS bf16x8*)(kb), b1 = *(const LAS bf16x8*)(kb + 512);
      p0 = __builtin_amdgcn_mfma_f32_32x32x16_bf16(b0, qr[0], ci, 0, 0, 0); p1 = __builtin_amdgcn_mfma_f32_32x32x16_bf16(b1, qr[0], ci, 0, 0, 0); }
#pragma unroll
    for (int d0 = 1; d0 < 4; ++d0) { const bf16x8 b0 = *(const LAS bf16x8*)(kb + d0 * 2048), b1 = *(const LAS bf16x8*)(kb + d0 * 2048 + 512);
        p0 = __builtin_amdgcn_mfma_f32_32x32x16_bf16(b0, qr[d0], p0, 0, 0, 0); p1 = __builtin_amdgcn_mfma_f32_32x32x16_bf16(b1, qr[d0], p1, 0, 0, 0); }
}
__device__ __forceinline__ void pvT(f32x16 (&o)[2], const LAS unsigned char* vp, const f32x16& p0, const f32x16& p1, bool on = true) {
    u32x4 w0 = {cvtpk(p0[0], p0[1]), cvtpk(p0[2], p0[3]), cvtpk(p0[4], p0[5]), cvtpk(p0[6], p0[7])}, w1 = {cvtpk(p0[8], p0[9]), cvtpk(p0[10], p0[11]), cvtpk(p0[12], p0[13]), cvtpk(p0[14], p0[15])};
    u32x4 w2 = {cvtpk(p1[0], p1[1]), cvtpk(p1[2], p1[3]), cvtpk(p1[4], p1[5]), cvtpk(p1[6], p1[7])}, w3 = {cvtpk(p1[8], p1[9]), cvtpk(p1[10], p1[11]), cvtpk(p1[12], p1[13]), cvtpk(p1[14], p1[15])};
    { const unsigned onm = on ? 0xffffffffu : 0u; w0 &= onm; w1 &= onm; w2 &= onm; w3 &= onm; }
    const bf16x8 pa0 = __builtin_bit_cast(bf16x8, w0), pa1 = __builtin_bit_cast(bf16x8, w1), pa2 = __builtin_bit_cast(bf16x8, w2), pa3 = __builtin_bit_cast(bf16x8, w3);
#pragma unroll
    for (int d0 = 0; d0 < 2; ++d0) { s16x4 lo[4], hi[4];
#pragma unroll
        for (int ks = 0; ks < 4; ++ks) { lo[ks] = vtr(vp + d0 * 4096 + ks * 1024); hi[ks] = vtr(vp + d0 * 4096 + ks * 1024 + 512); }
#define NSA_PK(k) __builtin_shufflevector(lo[k], hi[k], 0, 1, 2, 3, 4, 5, 6, 7)
        o[d0] = __builtin_amdgcn_mfma_f32_32x32x16_bf16(NSA_PK(0), pa0, o[d0], 0, 0, 0);
        o[d0] = __builtin_amdgcn_mfma_f32_32x32x16_bf16(NSA_PK(1), pa1, o[d0], 0, 0, 0);
        o[d0] = __builtin_amdgcn_mfma_f32_32x32x16_bf16(NSA_PK(2), pa2, o[d0], 0, 0, 0);
        o[d0] = __builtin_amdgcn_mfma_f32_32x32x16_bf16(NSA_PK(3), pa3, o[d0], 0, 0, 0);
#undef NSA_PK
    }
}
__device__ __forceinline__ float max32(const f32x16& p0, const f32x16& p1) {
    float a = __builtin_fmaxf(__builtin_fmaxf(p0[0], p0[1]), p1[0]), b = __builtin_fmaxf(__builtin_fmaxf(p0[2], p0[3]), p1[1]); a = __builtin_fmaxf(__builtin_fmaxf(a, p1[2]), p1[3]);
#pragma unroll
    for (int r = 4; r < 16; r += 4) { a = __builtin_fmaxf(__builtin_fmaxf(a, p0[r]), p0[r + 1]); b = __builtin_fmaxf(__builtin_fmaxf(b, p0[r + 2]), p0[r + 3]); a = __builtin_fmaxf(__builtin_fmaxf(a, p1[r]), p1[r + 1]); b = __builtin_fmaxf(__builtin_fmaxf(b, p1[r + 2]), p1[r + 3]); }
    return __builtin_fmaxf(a, b); }
__device__ __forceinline__ float sum32(const f32x16& p0, const f32x16& p1) { float a = p0[0] + p1[0];
#pragma unroll
    for (int r = 1; r < 16; ++r) a += p0[r] + p1[r];
    return a; }

__device__ __forceinline__ void issue_step(int step, unsigned slot, int ncmp, int nslc, int c, int b, int g, const bf16* P, const bf16* KCb, const bf16* VCb, unsigned lds0, int wid, unsigned kofP, unsigned vofP, unsigned kofC, unsigned vofC) {
    const unsigned kd = (unsigned)__builtin_amdgcn_readfirstlane(lds0 + L_K + slot + wid * 1024), vd = (unsigned)__builtin_amdgcn_readfirstlane(lds0 + L_V + slot + wid * 1024);
    if (step < ncmp) { const int j = step; glds16s(KCb + (size_t)j * 64 * 64, kofC, kd); glds16s(VCb + (size_t)j * 64 * 64, vofC, vd); }
    else { int s, kc, vc; if (step < ncmp + nslc) { s = step - ncmp; kc = PC_NKS; vc = PC_NVS; } else { s = c - (step - ncmp - nslc); kc = PC_NKW; vc = PC_NVW; }
        const bf16* base = P + (size_t)(b * 4096 + 64 * s) * PP + 64 * g; glds16s(base + kc, kofP, kd); glds16s(base + vc, vofP, vd); }
}

__device__ __forceinline__ void unit(LAS unsigned char* lds, const bf16* P, const bf16* KCall, bf16* MIX, const float* gate_bias  , int b, int g, int c) {
    const int tid = threadIdx.x, lane = tid & 63, r32 = lane & 31, hi = lane >> 5; const int wid = __builtin_amdgcn_readfirstlane(tid >> 6);
    const int hr = wid & 3, th = wid >> 2, hq = 4 * g + hr;
    const int tl = 32 * th + r32;
    const int row = b * 4096 + 64 * c + tl;
    const unsigned lds0 = (unsigned)(uintptr_t)lds;
    const bf16* KCb = KCall + (size_t)(b * 2 + g) * 256 * 64; const bf16* VCb = KCb + (size_t)4 * 2 * 256 * 64;
    const int ncmp = (min(255, 4 * c + 3) + 63) >> 6, nslc = c + 1, nwin = min(c + 1, 9), nsteps = ncmp + nslc + nwin;
    const unsigned kofP = (unsigned)(lane * PP + wid * 8) * 2u, vofP = (unsigned)((16 * (wid & 3) + (lane >> 2)) * PP + (wid >> 2) * 32 + (lane & 3) * 8) * 2u;
    const unsigned kofC = (unsigned)(lane * 64 + wid * 8) * 2u, vofC = (unsigned)((16 * (wid & 3) + (lane >> 2)) * 64 + (wid >> 2) * 32 + (lane & 3) * 8) * 2u;
#define issue(st, sl) issue_step((st), (sl), ncmp, nslc, c, b, g, P, KCb, VCb, lds0, wid, kofP, vofP, kofC, vofC)
    issue(0, 0u); issue(1, (unsigned)SLOTB);
    bf16x8 qraw[4], qrot[4];
    { const bf16* qp = P + (size_t)row * PP + 64 * hq + 8 * hi;
#pragma unroll
      for (int d0 = 0; d0 < 4; ++d0) { qraw[d0] = *(const bf16x8*)(qp + PC_NQRAW + 16 * d0); qrot[d0] = *(const bf16x8*)(qp + PC_NQROT + 16 * d0); } }
    float gt0, gt1, gt2;
    { const bf16* gl = P + (size_t)row * PP + PC_NGATE + 3 * hq; const float* gb = gate_bias + 3 * hq;
      gt0 = 1.0f / (1.0f + __expf(-(bf2f(gl[0]) + gb[0]))); gt1 = 1.0f / (1.0f + __expf(-(bf2f(gl[1]) + gb[1]))); gt2 = 1.0f / (1.0f + __expf(-(bf2f(gl[2]) + gb[2]))); }
    asm volatile("s_waitcnt vmcnt(0)" ::: "memory");
    const LAS unsigned char* kbase = lds + L_K + hi * 1024 + r32 * 16;
    const LAS unsigned char* vbase = lds + L_V + ((lane >> 4) & 1) * 32 + (lane & 3) * 8 + (4 * hi + ((lane & 15) >> 2)) * 64;
    int step = 0; unsigned scur = 2u * SLOTB;
#define NSA_BEGIN() do { if (step + 1 < nsteps) { NSA_WAIT_BAR(2); } else { NSA_WAIT_BAR(0); } const unsigned s2_ = scur; scur = (scur == 2u * SLOTB) ? 0u : scur + SLOTB; if (step + 2 < nsteps) issue(step + 2, s2_); } while (0)
    const float NEG = -INFINITY;
    const int t = 64 * c + tl; const int nvalid = (t >= 31) ? min(255, ((t - 31) >> 4) + 1) : 0;
    f32x16 p0, p1; f32x16 acc[2], o[2];
    float m = -1e30f, l = 0.f; float mt[4] = {0.f, 0.f, 0.f, 0.f};
    o[0] = f32x16{}; o[1] = f32x16{};
    { LAS float* imp = (LAS float*)(lds + L_IMP) + (hr * 64 + tl) * IMP_PITCH + hi;
      float xprev = 0.f;
#pragma unroll
      for (int j = 0; j < 4; ++j) { if (j < ncmp) {
        NSA_BEGIN();
        qkt(p0, p1, kbase + scur, qraw);
        const int thr = nvalid - 64 * j - 4 * hi;
#pragma unroll
        for (int r = 0; r < 16; ++r) { const int cb = (r & 3) + 8 * (r >> 2); if (cb >= thr) p0[r] = NEG; if (cb + 32 >= thr) p1[r] = NEG; }
        const float mn = fmaxf(m, both_max(max32(p0, p1))); const float al = __builtin_amdgcn_exp2f(m - mn); m = mn; mt[j] = mn;
#pragma unroll
        for (int r = 0; r < 16; ++r) { p0[r] = __builtin_amdgcn_exp2f(p0[r] - mn); p1[r] = __builtin_amdgcn_exp2f(p1[r] - mn); }
        l = l * al + sum32(p0, p1); xprev *= al;
        if (__any(al != 1.0f)) {
#pragma unroll
            for (int r = 0; r < 16; ++r) { o[0][r] *= al; o[1][r] *= al; } }
#pragma unroll
        for (int hf = 0; hf < 2; ++hf)
#pragma unroll
            for (int a = 0; a < 4; ++a) { const f32x16& pp = hf ? p1 : p0; const float G = (pp[4 * a] + pp[4 * a + 1]) + (pp[4 * a + 2] + pp[4 * a + 3]); const float X = partner(pp[4 * a + 3], hi);
                imp[2 * (8 * j + 4 * hf + a)] = G + (hi ? X : xprev); xprev = X; }
        pvT(o, vbase + scur, p0, p1);
        ++step; } }
      const float lt = both_sum(l); const float linv = lt > 0.f ? 1.0f / lt : 0.f;
      if (hi == 0) { LAS float* fac = (LAS float*)(lds + L_FAC) + (hr * 64 + tl) * 4;
#pragma unroll
          for (int j = 0; j < 4; ++j) fac[j] = (j < ncmp) ? __builtin_amdgcn_exp2f(mt[j] - m) * linv : 0.f; }
#pragma unroll
      for (int d0 = 0; d0 < 2; ++d0)
#pragma unroll
          for (int r = 0; r < 16; ++r) acc[d0][r] = (gt0 * linv) * o[d0][r];
    }
    asm volatile("s_waitcnt lgkmcnt(0)\n\ts_barrier" ::: "memory");
    { const LAS float* impb = (const LAS float*)(lds + L_IMP); LAS unsigned long long* sel = (LAS unsigned long long*)(lds + L_SEL);
      for (int tt = 0; tt < 8; ++tt) { const int tok = 8 * wid + tt;
        const LAS float* facb = (const LAS float*)(lds + L_FAC) + tok * 4 + (lane >> 4);
        const float v = ((impb[(0 * 64 + tok) * IMP_PITCH + lane] * facb[0] + impb[(1 * 64 + tok) * IMP_PITCH + lane] * facb[256]) + impb[(2 * 64 + tok) * IMP_PITCH + lane] * facb[512]) + impb[(3 * 64 + tok) * IMP_PITCH + lane] * facb[768];
        const bool forced = (lane == 0) || (lane == c) || (lane == c - 1);
        const float val = forced ? 1e4f : (lane <= c ? v : -1.0f);
        const unsigned ub = __float_as_uint(val); const unsigned key = (ub & 0x80000000u) ? ~ub : (ub | 0x80000000u);
        unsigned T = 0u;
#pragma unroll 8
        for (int bit = 31; bit >= 0; --bit) { const unsigned cand = T | (1u << bit); if (__popcll(__ballot(key >= cand)) >= 16) T = cand; }
        const unsigned long long gtm = __ballot(key > T), eqm = __ballot(key == T);
        const int need = 16 - __popcll(gtm);
        const int eqrank = __popcll(eqm & ((1ull << lane) - 1ull));
        const unsigned long long mk = gtm | __ballot(key == T && eqrank < need);
        if (lane == 0) sel[tok] = mk; } }
    asm volatile("s_waitcnt lgkmcnt(0)\n\ts_barrier" ::: "memory");
    const unsigned long long selm = ((const LAS unsigned long long*)(lds + L_SEL))[tl];
#define NSA_SOFTMAX_PV(FIRST, ON) do { \
        float mx = both_max(max32(p0, p1)); if (!(ON)) mx = 0.f; \
        if (__any(m != 0.f || mx > 60.0f || ((FIRST) && mx < -60.0f))) { \
            const float mxs = mx - m; const float dl = ((FIRST) || mxs > 8.0f) ? mxs : 0.f; m += dl; \
            _Pragma("unroll") for (int r = 0; r < 16; ++r) { p0[r] -= m; p1[r] -= m; } \
            const float al = __builtin_amdgcn_exp2f(-dl); l *= al; \
            _Pragma("unroll") for (int r = 0; r < 16; ++r) { o[0][r] *= al; o[1][r] *= al; } } \
        _Pragma("unroll") for (int r = 0; r < 16; ++r) { p0[r] = __builtin_amdgcn_exp2f(p0[r]); p1[r] = __builtin_amdgcn_exp2f(p1[r]); } \
        { const float ps_ = sum32(p0, p1); l += (ON) ? ps_ : 0.f; } \
        pvT(o, vbase + scur, p0, p1, (ON)); } while (0)
    o[0] = f32x16{}; o[1] = f32x16{}; m = 0.f; l = 0.f;
    for (int s = 0; s < nslc; ++s, ++step) {
        NSA_BEGIN();
        const bool on = (selm >> s) & 1ull;
        qkt(p0, p1, kbase + scur, qrot);
        if (s == c) { const int thr = tl - 4 * hi;
#pragma unroll
            for (int r = 0; r < 16; ++r) { const int cb = (r & 3) + 8 * (r >> 2); if (cb > thr) p0[r] = NEG; if (cb + 32 > thr) p1[r] = NEG; } }
        NSA_SOFTMAX_PV(s == 0, on);
    }
    { const float sc = gt1 / both_sum(l);
#pragma unroll
      for (int d0 = 0; d0 < 2; ++d0)
#pragma unroll
          for (int r = 0; r < 16; ++r) acc[d0][r] += sc * o[d0][r]; }
    o[0] = f32x16{}; o[1] = f32x16{}; m = 0.f; l = 0.f;
    for (int i = 0; i < nwin; ++i, ++step) {
        NSA_BEGIN();
        qkt(p0, p1, kbase + scur, qrot);
        if (i == 0) { const int thr = tl - 4 * hi;
#pragma unroll
            for (int r = 0; r < 16; ++r) { const int cb = (r & 3) + 8 * (r >> 2); if (cb > thr) p0[r] = NEG; if (cb + 32 > thr) p1[r] = NEG; } }
        if (i == 8) { const int thr = tl - 4 * hi;
#pragma unroll
            for (int r = 0; r < 16; ++r) { const int cb = (r & 3) + 8 * (r >> 2); if (cb <= thr) p0[r] = NEG; if (cb + 32 <= thr) p1[r] = NEG; } }
        NSA_SOFTMAX_PV(i == 0, true);
    }
    { const float sc = gt2 / both_sum(l);
#pragma unroll
      for (int d0 = 0; d0 < 2; ++d0)
#pragma unroll
          for (int r = 0; r < 16; ++r) acc[d0][r] += sc * o[d0][r]; }
#undef NSA_SOFTMAX_PV
#undef NSA_BEGIN
#undef issue
    { LAS unsigned char* stg = lds + L_IMP + wid * (32 * STG_PITCH);
#pragma unroll
      for (int d0 = 0; d0 < 2; ++d0)
#pragma unroll
          for (int r = 0; r < 16; r += 2) { const int d = 32 * d0 + (r & 3) + 8 * (r >> 2) + 4 * hi; *(LAS unsigned*)(stg + r32 * STG_PITCH + d * 2) = cvtpk(acc[d0][r], acc[d0][r + 1]); }
      asm volatile("s_waitcnt lgkmcnt(0)" ::: "memory");
      bf16* orow = MIX + (size_t)(b * 4096 + 64 * c + 32 * th) * 1024 + 256 + 64 * hq;
#pragma unroll
      for (int i = 0; i < 4; ++i) { const int rr = i * 8 + (lane >> 3), ch = lane & 7; const u32x2 a = *(const LAS u32x2*)(stg + rr * STG_PITCH + ch * 16), bq = *(const LAS u32x2*)(stg + rr * STG_PITCH + ch * 16 + 8);
          u32x4 v = {a.x, a.y, bq.x, bq.y}; *(u32x4*)(orow + (size_t)rr * 1024 + ch * 8) = v; } }
    asm volatile("s_waitcnt lgkmcnt(0)\n\ts_barrier" ::: "memory");
}

constexpr int NSLOT = 7, TSLOT = 2 * SLOTB, F_IMP = 3 * TSLOT, F_SEL = F_IMP + 4 * 64 * IMP_PITCH * 4, F_FAC = F_SEL + 512, F_FLAG = 122880, F_END = F_FLAG + 64;
static_assert(F_FAC + 4 * 64 * 4 * 4 <= F_FLAG && NSLOT * TSLOT <= F_SEL, "nsa fast LDS map");
static_assert(F_END <= 131072, "nsa fast LDS map");
__device__ __forceinline__ void issue_fast(int step, unsigned slot  , int ncmp, int nslc, int c, int b, int g, const bf16* P, const bf16* KCb, const bf16* VCb, unsigned lds0, int wid, unsigned kofP, unsigned vofP, unsigned kofC, unsigned vofC) {
    const unsigned kd = (unsigned)__builtin_amdgcn_readfirstlane(lds0 + slot + wid * 1024), vd = kd + SLOTB;
    if (step < ncmp) { const int j = step; glds16s(KCb + (size_t)j * 64 * 64, kofC, kd); glds16s(VCb + (size_t)j * 64 * 64, vofC, vd); }
    else { int s, kc, vc; if (step < ncmp + nslc) { s = step - ncmp; kc = PC_NKS; vc = PC_NVS; } else { s = c - (step - ncmp - nslc); kc = PC_NKW; vc = PC_NVW; }
        const bf16* base = P + (size_t)(b * 4096 + 64 * s) * PP + 64 * g; glds16s(base + kc, kofP, kd); glds16s(base + vc, vofP, vd); }
}
#define SBAR() __builtin_amdgcn_sched_barrier(0)
__device__ __forceinline__ bool unit_fast(LAS unsigned char* lds, const bf16* P, const bf16* KCall, bf16* MIX, const float* gate_bias, int b, int g, int c) {
    const int tid = threadIdx.x, lane = tid & 63, r32 = lane & 31, hi = lane >> 5; const int wid = __builtin_amdgcn_readfirstlane(tid >> 6);
    const int hr = wid & 3, th = wid >> 2, hq = 4 * g + hr;
    const int tl = 32 * th + r32;
    const int row = b * 4096 + 64 * c + tl;
    const unsigned lds0 = (unsigned)(uintptr_t)lds;
    const bf16* KCb = KCall + (size_t)(b * 2 + g) * 256 * 64; const bf16* VCb = KCb + (size_t)4 * 2 * 256 * 64;
    const int ncmp = (min(255, 4 * c + 3) + 63) >> 6, nslc = c + 1, nwin = min(c + 1, 9), nsteps = ncmp + nslc + nwin;
    const unsigned kofP = (unsigned)(lane * PP + wid * 8) * 2u, vofP = (unsigned)((16 * (wid & 3) + (lane >> 2)) * PP + (wid >> 2) * 32 + (lane & 3) * 8) * 2u;
    const unsigned kofC = (unsigned)(lane * 64 + wid * 8) * 2u, vofC = (unsigned)((16 * (wid & 3) + (lane >> 2)) * 64 + (wid >> 2) * 32 + (lane & 3) * 8) * 2u;
#define issue(st, sl) issue_fast((st), (sl), ncmp, nslc, c, b, g, P, KCb, VCb, lds0, wid, kofP, vofP, kofC, vofC)
    issue(0, 0u); if (ncmp > 1) issue(1, (unsigned)TSLOT);
    bf16x8 qraw[4], qrot[4];
    { const bf16* qp = P + (size_t)row * PP + 64 * hq + 8 * hi;
#pragma unroll
      for (int d0 = 0; d0 < 4; ++d0) { qraw[d0] = *(const bf16x8*)(qp + PC_NQRAW + 16 * d0); qrot[d0] = *(const bf16x8*)(qp + PC_NQROT + 16 * d0); } }
    float gt0, gt1, gt2;
    { const bf16* gl = P + (size_t)row * PP + PC_NGATE + 3 * hq; const float* gb = gate_bias + 3 * hq;
      gt0 = 1.0f / (1.0f + __expf(-(bf2f(gl[0]) + gb[0]))); gt1 = 1.0f / (1.0f + __expf(-(bf2f(gl[1]) + gb[1]))); gt2 = 1.0f / (1.0f + __expf(-(bf2f(gl[2]) + gb[2]))); }
    if (tid == 0) *(LAS unsigned*)(lds + F_FLAG) = 0u;
    asm volatile("s_waitcnt vmcnt(0)" ::: "memory");
    const LAS unsigned char* kbase = lds + hi * 1024 + r32 * 16;
    const LAS unsigned char* vbase = lds + SLOTB + ((lane >> 4) & 1) * 32 + (lane & 3) * 8 + (4 * hi + ((lane & 15) >> 2)) * 64;
    int step = 0; unsigned scur = 0u;
#define NSA_BEGIN() do { if (step + 1 < ncmp) { NSA_WAIT_BAR(2); } else { NSA_WAIT_BAR(0); } \
        if (step + 2 < ncmp) issue(step + 2, (scur == 0u ? 2u * TSLOT : scur - TSLOT)); } while (0)
#define NSA_NEXT() do { ++step; scur = (scur == 2u * TSLOT) ? 0u : scur + TSLOT; } while (0)
    const float NEG = -INFINITY;
    const int t = 64 * c + tl; const int nvalid = (t >= 31) ? min(255, ((t - 31) >> 4) + 1) : 0;
    f32x16 p0, p1; f32x16 acc[2], o[2];
    bool bad = false;
    float m = -1e30f, l = 0.f; float mt[4] = {0.f, 0.f, 0.f, 0.f};
    o[0] = f32x16{}; o[1] = f32x16{};
    { LAS float* imp = (LAS float*)(lds + F_IMP) + (hr * 64 + tl) * IMP_PITCH + hi;
      float xprev = 0.f;
#pragma unroll
      for (int j = 0; j < 4; ++j) { if (j < ncmp) {
        NSA_BEGIN();
        qkt(p0, p1, kbase + scur, qraw);
        const int thr = nvalid - 64 * j - 4 * hi;
#pragma unroll
        for (int r = 0; r < 16; ++r) { const int cb = (r & 3) + 8 * (r >> 2); if (cb >= thr) p0[r] = NEG; if (cb + 32 >= thr) p1[r] = NEG; }
        const float mn = fmaxf(m, both_max(max32(p0, p1))); const float al = __builtin_amdgcn_exp2f(m - mn); m = mn; mt[j] = mn;
#pragma unroll
        for (int r = 0; r < 16; ++r) { p0[r] = __builtin_amdgcn_exp2f(p0[r] - mn); p1[r] = __builtin_amdgcn_exp2f(p1[r] - mn); }
        l = l * al + sum32(p0, p1); xprev *= al;
        if (__any(al != 1.0f)) {
#pragma unroll
            for (int r = 0; r < 16; ++r) { o[0][r] *= al; o[1][r] *= al; } }
#pragma unroll
        for (int hf = 0; hf < 2; ++hf)
#pragma unroll
            for (int a = 0; a < 4; ++a) { const f32x16& pp = hf ? p1 : p0; const float G = (pp[4 * a] + pp[4 * a + 1]) + (pp[4 * a + 2] + pp[4 * a + 3]); const float X = partner(pp[4 * a + 3], hi);
                imp[2 * (8 * j + 4 * hf + a)] = G + (hi ? X : xprev); xprev = X; }
        pvT(o, vbase + scur, p0, p1);
        NSA_NEXT(); } }
      const float lt = both_sum(l); const float linv = lt > 0.f ? 1.0f / lt : 0.f;
      if (hi == 0) { LAS float* fac = (LAS float*)(lds + F_FAC) + (hr * 64 + tl) * 4;
#pragma unroll
          for (int j = 0; j < 4; ++j) fac[j] = (j < ncmp) ? __builtin_amdgcn_exp2f(mt[j] - m) * linv : 0.f; }
#pragma unroll
      for (int d0 = 0; d0 < 2; ++d0)
#pragma unroll
          for (int r = 0; r < 16; ++r) acc[d0][r] = (gt0 * linv) * o[d0][r];
    }
#undef NSA_BEGIN
#undef NSA_NEXT
    const int ntot = nslc + nwin;
    asm volatile("s_waitcnt lgkmcnt(0)\n\ts_barrier" ::: "memory");
#define issue_j(j_) issue(ncmp + (j_), (unsigned)(((j_) % NSLOT) * TSLOT))
    issue_j(0); if (1 < ntot) issue_j(1); if (2 < ntot) issue_j(2);
    { const LAS float* impb = (const LAS float*)(lds + F_IMP); LAS unsigned long long* sel = (LAS unsigned long long*)(lds + F_SEL);
      for (int tt = 0; tt < 8; ++tt) { const int tok = 8 * wid + tt;
        const LAS float* facb = (const LAS float*)(lds + F_FAC) + tok * 4 + (lane >> 4);
        const float v = ((impb[(0 * 64 + tok) * IMP_PITCH + lane] * facb[0] + impb[(1 * 64 + tok) * IMP_PITCH + lane] * facb[256]) + impb[(2 * 64 + tok) * IMP_PITCH + lane] * facb[512]) + impb[(3 * 64 + tok) * IMP_PITCH + lane] * facb[768];
        const bool forced = (lane == 0) || (lane == c) || (lane == c - 1);
        const float val = forced ? 1e4f : (lane <= c ? v : -1.0f);
        const unsigned ub = __float_as_uint(val); const unsigned key = (ub & 0x80000000u) ? ~ub : (ub | 0x80000000u);
        unsigned T = 0u;
#pragma unroll 8
        for (int bit = 31; bit >= 0; --bit) { const unsigned cand = T | (1u << bit); if (__popcll(__ballot(key >= cand)) >= 16) T = cand; }
        const unsigned long long gtm = __ballot(key > T), eqm = __ballot(key == T);
        const int need = 16 - __popcll(gtm);
        const int eqrank = __popcll(eqm & ((1ull << lane) - 1ull));
        const unsigned long long mk = gtm | __ballot(key == T && eqrank < need);
        if (lane == 0) sel[tok] = mk; } }
    asm volatile("s_waitcnt lgkmcnt(0)\n\ts_barrier" ::: "memory");
    const unsigned long long selm = ((const LAS unsigned long long*)(lds + F_SEL))[tl];
    asm volatile("s_waitcnt lgkmcnt(0)\n\ts_barrier" ::: "memory");
    if (3 < ntot) issue_j(3); if (4 < ntot) issue_j(4);
#define NSA_BEGIN() do { const int rem_ = ntot - 1 - jt; \
        if (rem_ >= 4) { NSA_WAIT_BAR(8); } else if (rem_ == 3) { NSA_WAIT_BAR(6); } else if (rem_ == 2) { NSA_WAIT_BAR(4); } else if (rem_ == 1) { NSA_WAIT_BAR(2); } else { NSA_WAIT_BAR(0); } \
        if (jt + 5 < ntot) issue_j(jt + 5); } while (0)
#define NSA_NEXT() do { ++jt; sprev = scur; scur = (scur == (unsigned)((NSLOT - 1) * TSLOT)) ? 0u : scur + TSLOT; } while (0)
    int jt = 0; unsigned sprev = 0u; scur = 0u;
    o[0] = f32x16{}; o[1] = f32x16{}; l = 0.f;
    f32x16 s0, s1;
    bool pon = true;
#define NSA_TILEMASK(K_) do { const int k__ = (K_); \
        if (k__ == nslc - 1 || k__ == nslc) { const int thr = tl - 4 * hi; _Pragma("unroll") for (int r = 0; r < 16; ++r) { const int cb = (r & 3) + 8 * (r >> 2); if (cb > thr) s0[r] = NEG; if (cb + 32 > thr) s1[r] = NEG; } } \
        if (k__ == nslc + 8) { const int thr = tl - 4 * hi; _Pragma("unroll") for (int r = 0; r < 16; ++r) { const int cb = (r & 3) + 8 * (r >> 2); if (cb <= thr) s0[r] = NEG; if (cb + 32 <= thr) s1[r] = NEG; } } } while (0)
    { NSA_BEGIN();
      qkt(s0, s1, kbase + scur, qrot); NSA_TILEMASK(0);
      const float mx = both_max(max32(s0, s1)); bad |= (mx > 60.0f) || (mx < -60.0f);
#pragma unroll
      for (int r = 0; r < 16; ++r) { s0[r] = __builtin_amdgcn_exp2f(s0[r]); s1[r] = __builtin_amdgcn_exp2f(s1[r]); }
      p0 = s0; p1 = s1; pon = true; NSA_NEXT(); }
    for (int k = 1; k < ntot; ++k) {
        NSA_BEGIN();
        const LAS unsigned char* kb = kbase + scur; const LAS unsigned char* vp = vbase + sprev;
        bf16x8 kf[8];
#pragma unroll
        for (int d0 = 0; d0 < 4; ++d0) { kf[2 * d0] = *(const LAS bf16x8*)(kb + d0 * 2048); kf[2 * d0 + 1] = *(const LAS bf16x8*)(kb + d0 * 2048 + 512); }
        SBAR();
        s16x4 vlo[8], vhi[8]; u32x4 pw[4]; float sacc = 0.f;
        const unsigned onm = pon ? 0xffffffffu : 0u;
#define NSA_GAPA(I, FR, PP_, PB, W, WC) do { \
        vlo[FR] = vtr(vp + ((FR) >> 2) * 4096 + ((FR) & 3) * 1024); vhi[FR] = vtr(vp + ((FR) >> 2) * 4096 + ((FR) & 3) * 1024 + 512); SBAR(); \
        if ((I) & 1) s1 = __builtin_amdgcn_mfma_f32_32x32x16_bf16(kf[I], qrot[(I) >> 1], (I) < 2 ? f32x16{} : s1, 0, 0, 0); else s0 = __builtin_amdgcn_mfma_f32_32x32x16_bf16(kf[I], qrot[(I) >> 1], (I) < 2 ? f32x16{} : s0, 0, 0, 0); \
        sacc += (PP_[PB] + PP_[PB + 1]) + (PP_[PB + 2] + PP_[PB + 3]); \
        pw[W][WC] = cvtpk(PP_[PB], PP_[PB + 1]) & onm; pw[W][WC + 1] = cvtpk(PP_[PB + 2], PP_[PB + 3]) & onm; SBAR(); } while (0)
        NSA_GAPA(0, 0, p0, 0, 0, 0);  NSA_GAPA(1, 4, p0, 4, 0, 2);  NSA_GAPA(2, 1, p0, 8, 1, 0);  NSA_GAPA(3, 5, p0, 12, 1, 2);
        NSA_GAPA(4, 2, p1, 0, 2, 0);  NSA_GAPA(5, 6, p1, 4, 2, 2);  NSA_GAPA(6, 3, p1, 8, 3, 0);  NSA_GAPA(7, 7, p1, 12, 3, 2);
#undef NSA_GAPA
        l += pon ? sacc : 0.f;
        NSA_TILEMASK(k);
        const bool on = (k < nslc) ? (bool)((selm >> k) & 1ull) : true;
        { const float mx = both_max(max32(s0, s1)); bad |= on && (mx > 60.0f || ((k == nslc) && mx < -60.0f)); }
        SBAR();
#define NSA_VFR(FR) __builtin_shufflevector(vlo[FR], vhi[FR], 0, 1, 2, 3, 4, 5, 6, 7)
#define NSA_GAPB(FR, SS, SB) do { o[(FR) >> 2] = __builtin_amdgcn_mfma_f32_32x32x16_bf16(NSA_VFR(FR), __builtin_bit_cast(bf16x8, pw[(FR) & 3]), o[(FR) >> 2], 0, 0, 0); \
        SS[SB] = __builtin_amdgcn_exp2f(SS[SB]); SS[SB + 1] = __builtin_amdgcn_exp2f(SS[SB + 1]); SS[SB + 2] = __builtin_amdgcn_exp2f(SS[SB + 2]); SS[SB + 3] = __builtin_amdgcn_exp2f(SS[SB + 3]); SBAR(); } while (0)
        NSA_GAPB(0, s0, 0); NSA_GAPB(4, s0, 4); NSA_GAPB(1, s0, 8); NSA_GAPB(5, s0, 12);
        NSA_GAPB(2, s1, 0); NSA_GAPB(6, s1, 4); NSA_GAPB(3, s1, 8); NSA_GAPB(7, s1, 12);
#undef NSA_GAPB
        if (k == nslc) {
            const float sc = gt1 / both_sum(l);
#pragma unroll
            for (int d0 = 0; d0 < 2; ++d0)
#pragma unroll
                for (int r = 0; r < 16; ++r) { acc[d0][r] += sc * o[d0][r]; o[d0][r] = 0.f; }
            l = 0.f; }
        p0 = s0; p1 = s1; pon = on;
        NSA_NEXT();
    }
    { float sacc = sum32(p0, p1); l += pon ? sacc : 0.f;
      asm volatile("s_waitcnt lgkmcnt(0)\n\ts_barrier" ::: "memory");
      pvT(o, vbase + sprev, p0, p1, pon);
      const float sc = gt2 / both_sum(l);
#pragma unroll
      for (int d0 = 0; d0 < 2; ++d0)
#pragma unroll
          for (int r = 0; r < 16; ++r) acc[d0][r] += sc * o[d0][r]; }
#undef NSA_VFR
#undef NSA_TILEMASK
#undef NSA_BEGIN
#undef NSA_NEXT
#undef issue_j
#undef issue
    if (__any(bad) && lane == 0) *(LAS unsigned*)(lds + F_FLAG) = 1u;
    asm volatile("s_waitcnt lgkmcnt(0)\n\ts_barrier" ::: "memory");
    const bool redo = *(const LAS unsigned*)(lds + F_FLAG) != 0u;
    if (!redo) {
      LAS unsigned char* stg = lds + F_IMP + wid * (32 * STG_PITCH);
#pragma unroll
      for (int d0 = 0; d0 < 2; ++d0)
#pragma unroll
          for (int r = 0; r < 16; r += 2) { const int d = 32 * d0 + (r & 3) + 8 * (r >> 2) + 4 * hi; *(LAS unsigned*)(stg + r32 * STG_PITCH + d * 2) = cvtpk(acc[d0][r], acc[d0][r + 1]); }
      asm volatile("s_waitcnt lgkmcnt(0)" ::: "memory");
      bf16* orow = MIX + (size_t)(b * 4096 + 64 * c + 32 * th) * 1024 + 256 + 64 * hq;
#pragma unroll
      for (int i = 0; i < 4; ++i) { const int rr = i * 8 + (lane >> 3), ch = lane & 7; const u32x2 a = *(const LAS u32x2*)(stg + rr * STG_PITCH + ch * 16), bq = *(const LAS u32x2*)(stg + rr * STG_PITCH + ch * 16 + 8);
          u32x4 v = {a.x, a.y, bq.x, bq.y}; *(u32x4*)(orow + (size_t)rr * 1024 + ch * 8) = v; } }
    asm volatile("s_waitcnt lgkmcnt(0)\n\ts_barrier" ::: "memory");
    return redo;
}
#undef SBAR
#undef NSA_WAIT_BAR
}


namespace ck {
using nsa::bf16x8; using nsa::s16x4; using nsa::f32x16; using nsa::u32x4; using nsa::u32x2; using nsa::glds16; using nsa::both_sum; using nsa::cvtpk; using nsa::qkt; using nsa::pvT;
__device__ __forceinline__ int offk(int row, int d) { return (d >> 3) * 1024 + row * 16 + (d & 7) * 2; }
__device__ __forceinline__ int offv(int row, int d) { return (d >> 5) * 4096 + (row >> 4) * 1024 + (row & 15) * 64 + (d & 31) * 2; }
__device__ __forceinline__ void dma_tile_k(const bf16* T, int pitch, unsigned dst, int lane) {
#pragma unroll
    for (int c = 0; c < 8; ++c) glds16(T + (size_t)lane * pitch + c * 8, (unsigned)__builtin_amdgcn_readfirstlane(dst + c * 1024)); }
__device__ __forceinline__ void dma_tile_v(const bf16* T, int pitch, unsigned dst, int lane) {
#pragma unroll
    for (int p = 0; p < 8; ++p) glds16(T + (size_t)(16 * (p & 3) + (lane >> 2)) * pitch + (p >> 2) * 32 + (lane & 3) * 8, (unsigned)__builtin_amdgcn_readfirstlane(dst + p * 1024)); }
__device__ __forceinline__ bf16x8 trfrag(int tb, int cb, int ks) { s16x4 lo, hi;
    asm volatile("ds_read_b64_tr_b16 %0,%1" : "=&v"(lo) : "v"(tb + cb * 4096 + ks * 1024) : "memory");
    asm volatile("ds_read_b64_tr_b16 %0,%1" : "=&v"(hi) : "v"(tb + cb * 4096 + ks * 1024 + 512) : "memory");
    asm volatile("s_waitcnt lgkmcnt(0)" ::: "memory");
    return (bf16x8){lo[0], lo[1], lo[2], lo[3], hi[0], hi[1], hi[2], hi[3]}; }

template <bool WANT_Q, bool KB_KLAYOUT>
__device__ __forceinline__ float gla_prepass(LAS unsigned char* bufq, LAS unsigned char* bufk, const bf16* P, int row0, int h, const float* a2  , const float* ab  , int lane) {
    float a2c[16];
#pragma unroll
    for (int j = 0; j < 16; ++j) a2c[j] = a2[j * 256 + lane];
    const float bias = ab[lane];
    const u32x4 g0 = *(const u32x4*)(P + (size_t)(row0 + lane) * PP + PC_GLR), g1 = *(const u32x4*)(P + (size_t)(row0 + lane) * PP + PC_GLR + 8);
    const unsigned G[8] = {g0.x, g0.y, g0.z, g0.w, g1.x, g1.y, g1.z, g1.w};
    if (WANT_Q) { dma_tile_k(P + (size_t)row0 * PP + PC_GQ + 64 * h, PP, (unsigned)(uintptr_t)bufq, lane); dma_tile_k(P + (size_t)row0 * PP + PC_GK + 64 * h, PP, (unsigned)(uintptr_t)bufk, lane); }
    else dma_tile_k(P + (size_t)row0 * PP + PC_GK + 64 * h, PP, (unsigned)(uintptr_t)bufq, lane);
    asm volatile("s_waitcnt vmcnt(0)" ::: "memory");
    const LAS unsigned char* ksrc = WANT_Q ? bufk : bufq;
    float run = 0.f;
#pragma unroll 4
    for (int i = 0; i < 64; ++i) {
        float z = bias;
#pragma unroll
        for (int w = 0; w < 8; ++w) { const unsigned gw = (unsigned)__builtin_amdgcn_readlane((int)G[w], i); z += __uint_as_float(gw << 16) * a2c[2 * w] + __uint_as_float(gw & 0xffff0000u) * a2c[2 * w + 1]; }
        const float la = (fminf(z, 0.f) - 0.6931471805599453f * __builtin_amdgcn_logf(1.0f + __builtin_amdgcn_exp2f(-1.4426950408889634f * fabsf(z)))) * 0.0625f;
        run += la;
        const float e1 = __builtin_amdgcn_exp2f(1.4426950408889634f * run), e2 = __builtin_amdgcn_exp2f(-1.4426950408889634f * run);
        const float kq = bf2f(*(const LAS unsigned short*)(ksrc + offk(i, lane))) * e2;
        if (WANT_Q) { const float qq = bf2f(*(const LAS unsigned short*)(bufq + offk(i, lane))) * e1; *(LAS unsigned short*)(bufq + offk(i, lane)) = (unsigned short)f2bf(qq); }
        *(LAS unsigned short*)(bufk + (KB_KLAYOUT ? offk(i, lane) : offv(i, lane))) = (unsigned short)f2bf(kq);
    }
    return run;
}
__device__ __forceinline__ void kv_unit(LAS unsigned char* bufv, LAS unsigned char* bufk, const bf16* Vsrc, const bf16* Ksrc, float* KVT  , float colscale0, float colscale1, int lane) {
    const int r32 = lane & 31, hi = lane >> 5;
    dma_tile_v(Vsrc, PP, (unsigned)(uintptr_t)bufv, lane);
    if (Ksrc) dma_tile_v(Ksrc, PP, (unsigned)(uintptr_t)bufk, lane);
    asm volatile("s_waitcnt vmcnt(0) lgkmcnt(0)" ::: "memory");
    const int lanebase = ((lane >> 4) & 1) * 32 + (lane & 3) * 8 + (4 * hi + ((lane & 15) >> 2)) * 64;
    const int vb = (int)(uintptr_t)bufv + lanebase, kb = (int)(uintptr_t)bufk + lanebase;
    f32x16 o[2][2];
#pragma unroll
    for (int a = 0; a < 2; ++a)
#pragma unroll
        for (int c = 0; c < 2; ++c) o[a][c] = f32x16{};
#pragma unroll
    for (int ks = 0; ks < 4; ++ks) { const bf16x8 v0 = trfrag(vb, 0, ks), v1 = trfrag(vb, 1, ks), k0 = trfrag(kb, 0, ks), k1 = trfrag(kb, 1, ks);
        o[0][0] = __builtin_amdgcn_mfma_f32_32x32x16_bf16(v0, k0, o[0][0], 0, 0, 0); o[0][1] = __builtin_amdgcn_mfma_f32_32x32x16_bf16(v0, k1, o[0][1], 0, 0, 0);
        o[1][0] = __builtin_amdgcn_mfma_f32_32x32x16_bf16(v1, k0, o[1][0], 0, 0, 0); o[1][1] = __builtin_amdgcn_mfma_f32_32x32x16_bf16(v1, k1, o[1][1], 0, 0, 0); }
#pragma unroll
    for (int a = 0; a < 2; ++a)
#pragma unroll
        for (int c = 0; c < 2; ++c) { const float cs = c ? colscale1 : colscale0;
#pragma unroll
            for (int r = 0; r < 16; ++r) { const int v = 32 * a + (r & 3) + 8 * (r >> 2) + 4 * hi; KVT[v * 64 + 32 * c + r32] = o[a][c][r] * cs; } }
}
__device__ __forceinline__ void out_unit(f32x16 (&o)[2][2], const bf16x8 (&qf)[2][4], LAS unsigned char* bufk, LAS unsigned char* bufv, const bf16* Vsrc, const float* ST, float ascale, int lane) {
    const int r32 = lane & 31, hi = lane >> 5;
    dma_tile_v(Vsrc, PP, (unsigned)(uintptr_t)bufv, lane);
    bf16x8 sf[2][4];
#pragma unroll
    for (int a = 0; a < 2; ++a)
#pragma unroll
        for (int ks = 0; ks < 4; ++ks) { const float* sp = ST + (32 * a + r32) * 64 + 16 * ks + 8 * hi; const f32x4 s0 = *(const f32x4*)sp, s1 = *(const f32x4*)(sp + 4);
            u32x4 w = {cvtpk(s0[0], s0[1]), cvtpk(s0[2], s0[3]), cvtpk(s1[0], s1[1]), cvtpk(s1[2], s1[3])}; sf[a][ks] = __builtin_bit_cast(bf16x8, w); }
#pragma unroll
    for (int ib = 0; ib < 2; ++ib)
#pragma unroll
        for (int a = 0; a < 2; ++a) { o[ib][a] = f32x16{};
#pragma unroll
            for (int ks = 0; ks < 4; ++ks) o[ib][a] = __builtin_amdgcn_mfma_f32_32x32x16_bf16(sf[a][ks], qf[ib][ks], o[ib][a], 0, 0, 0); }
    asm volatile("s_waitcnt vmcnt(0) lgkmcnt(0)" ::: "memory");
    const LAS unsigned char* kbase = bufk + hi * 1024 + r32 * 16;
    const LAS unsigned char* vbase = bufv + ((lane >> 4) & 1) * 32 + (lane & 3) * 8 + (4 * hi + ((lane & 15) >> 2)) * 64;
#pragma unroll
    for (int ib = 0; ib < 2; ++ib) { f32x16 p0, p1; qkt(p0, p1, kbase, qf[ib]);
        const int thr = 32 * ib + r32 - 4 * hi;
#pragma unroll
        for (int r = 0; r < 16; ++r) { const int cb = (r & 3) + 8 * (r >> 2); p0[r] = (cb <= thr) ? p0[r] * ascale : 0.f; p1[r] = (cb + 32 <= thr) ? p1[r] * ascale : 0.f; }
        pvT(o[ib], vbase, p0, p1); }
}
}

__device__ __forceinline__ void gla_kv_wave(Frame& F, const Ptrs& I, int l, int u, LAS unsigned char* wbuf) {
    const int n = u & 63, h = (u >> 6) & 3, b = u >> 8, row0 = b * SEQ + 64 * n, lane = F.lane;
    const bf16* P = (const bf16*)(F.ws + WS_P);
    const float bl = ck::gla_prepass<false, false>(wbuf, wbuf + 8192, P, row0, h, I.gla_a2 + (size_t)l * 16 * 256 + 64 * h, I.gla_a_bias + (size_t)l * 256 + 64 * h, lane);
    const float eb = __expf(bl);
    ((float*)(F.ws + WS_GDEC))[u * 64 + lane] = eb;
    const float c0 = __shfl(eb, lane & 31), c1 = __shfl(eb, 32 + (lane & 31));
    ck::kv_unit(wbuf, wbuf + 8192, P + (size_t)row0 * PP + PC_GV + 64 * h, nullptr, (float*)(F.ws + WS_KVG) + (size_t)u * 4096, c0, c1, lane);
}
__device__ __forceinline__ void ret_kv_wave(Frame& F, int u, LAS unsigned char* wbuf) {
    const int n = u & 63, h = (u >> 6) & 3, b = u >> 8, row0 = b * SEQ + 64 * n;
    const bf16* P = (const bf16*)(F.ws + WS_P);
    ck::kv_unit(wbuf, wbuf + 8192, P + (size_t)row0 * PP + PC_RV + 64 * h, P + (size_t)row0 * PP + PC_RK + 64 * h, (float*)(F.ws + WS_KVR) + (size_t)u * 4096, 1.f, 1.f, F.lane);
}
__device__ __forceinline__ void gla_out_wave(Frame& F, const Ptrs& I, int l, int u, LAS unsigned char* wbuf, bf16* MIX) {
    const int n = u & 63, h = (u >> 6) & 3, b = u >> 8, row0 = b * SEQ + 64 * n, lane = F.lane, r32 = lane & 31, hi = lane >> 5;
    const bf16* P = (const bf16*)(F.ws + WS_P);
    (void)ck::gla_prepass<true, true>(wbuf, wbuf + 8192, P, row0, h, I.gla_a2 + (size_t)l * 16 * 256 + 64 * h, I.gla_a_bias + (size_t)l * 256 + 64 * h, lane);
    asm volatile("s_waitcnt lgkmcnt(0)" ::: "memory");
    ck::bf16x8 qf[2][4];
#pragma unroll
    for (int ib = 0; ib < 2; ++ib)
#pragma unroll
        for (int ks = 0; ks < 4; ++ks) qf[ib][ks] = *(const LAS ck::bf16x8*)(wbuf + (2 * ks + hi) * 1024 + (32 * ib + r32) * 16);
    asm volatile("s_waitcnt lgkmcnt(0)" ::: "memory");
    ck::f32x16 o[2][2];
    ck::out_unit(o, qf, wbuf + 8192, wbuf, P + (size_t)row0 * PP + PC_GV + 64 * h, (const float*)(F.ws + WS_KVG) + (size_t)u * 4096, 1.0f, lane);
    const float* gn = I.gla_norm_g + (size_t)l * 64;
#pragma unroll
    for (int ib = 0; ib < 2; ++ib) { float ss = 0.f;
#pragma unroll
        for (int a = 0; a < 2; ++a)
#pragma unroll
            for (int r = 0; r < 16; ++r) ss += o[ib][a][r] * o[ib][a][r];
        const float rstd = 1.f / sqrtf(ck::both_sum(ss) * (1.0f / 64.0f) + NORM_EPS);
        const size_t row = (size_t)(row0 + 32 * ib + r32);
#pragma unroll
        for (int a = 0; a < 2; ++a)
#pragma unroll
            for (int q4 = 0; q4 < 4; ++q4) { const int v = 32 * a + 8 * q4 + 4 * hi; const f32x4 g4 = *(const f32x4*)(gn + v);
                const ck::u32x2 gg = *(const ck::u32x2*)(P + row * PP + PC_GG + 64 * h + v);
                const float y0 = o[ib][a][4 * q4 + 0] * rstd * g4[0] * silu1(__uint_as_float(gg.x << 16)), y1 = o[ib][a][4 * q4 + 1] * rstd * g4[1] * silu1(__uint_as_float(gg.x & 0xffff0000u));
                const float y2 = o[ib][a][4 * q4 + 2] * rstd * g4[2] * silu1(__uint_as_float(gg.y << 16)), y3 = o[ib][a][4 * q4 + 3] * rstd * g4[3] * silu1(__uint_as_float(gg.y & 0xffff0000u));
                ck::u32x2 w = {ck::cvtpk(y0, y1), ck::cvtpk(y2, y3)}; *(ck::u32x2*)(MIX + row * D + 64 * h + v) = w; } }
}
__device__ __forceinline__ void ret_out_wave(Frame& F, const Ptrs& I, int l, int u, LAS unsigned char* wbuf, bf16* MIX) {
    const int n = u & 63, h = (u >> 6) & 3, b = u >> 8, row0 = b * SEQ + 64 * n, lane = F.lane, r32 = lane & 31, hi = lane >> 5;
    const bf16* P = (const bf16*)(F.ws + WS_P);
    ck::dma_tile_k(P + (size_t)row0 * PP + PC_RK + 64 * h, PP, (unsigned)(uintptr_t)(wbuf + 8192), lane);
    ck::bf16x8 qf[2][4];
#pragma unroll
    for (int ib = 0; ib < 2; ++ib)
#pragma unroll
        for (int ks = 0; ks < 4; ++ks) qf[ib][ks] = *(const ck::bf16x8*)(P + (size_t)(row0 + 32 * ib + r32) * PP + PC_RQ + 64 * h + 16 * ks + 8 * hi);
    ck::f32x16 o[2][2];
    const float ginv = exp2f(-64.0f * log2f(1.0f - exp2f(-5.0f - (float)h)));
    ck::out_unit(o, qf, wbuf + 8192, wbuf, P + (size_t)row0 * PP + PC_RV + 64 * h, (const float*)(F.ws + WS_KVR) + (size_t)u * 4096, ginv, lane);
    const float* gn = I.ret_norm_g + (size_t)l * 64;
#pragma unroll
    for (int ib = 0; ib < 2; ++ib) { float s1 = 0.f;
#pragma unroll
        for (int a = 0; a < 2; ++a)
#pragma unroll
            for (int r = 0; r < 16; ++r) s1 += o[ib][a][r];
        const float mean = ck::both_sum(s1) * (1.0f / 64.0f); float s2 = 0.f;
#pragma unroll
        for (int a = 0; a < 2; ++a)
#pragma unroll
            for (int r = 0; r < 16; ++r) { o[ib][a][r] -= mean; s2 += o[ib][a][r] * o[ib][a][r]; }
        const float rstd = 1.f / sqrtf(ck::both_sum(s2) * (1.0f / 64.0f) + NORM_EPS);
        const size_t row = (size_t)(row0 + 32 * ib + r32);
#pragma unroll
        for (int a = 0; a < 2; ++a)
#pragma unroll
            for (int q4 = 0; q4 < 4; ++q4) { const int v = 32 * a + 8 * q4 + 4 * hi; const f32x4 g4 = *(const f32x4*)(gn + v);
                const ck::u32x2 gg = *(const ck::u32x2*)(P + row * PP + PC_RG + 64 * h + v);
                const float y0 = o[ib][a][4 * q4 + 0] * rstd * g4[0] * silu1(__uint_as_float(gg.x << 16)), y1 = o[ib][a][4 * q4 + 1] * rstd * g4[1] * silu1(__uint_as_float(gg.x & 0xffff0000u));
                const float y2 = o[ib][a][4 * q4 + 2] * rstd * g4[2] * silu1(__uint_as_float(gg.y << 16)), y3 = o[ib][a][4 * q4 + 3] * rstd * g4[3] * silu1(__uint_as_float(gg.y & 0xffff0000u));
                ck::u32x2 w = {ck::cvtpk(y0, y1), ck::cvtpk(y2, y3)}; *(ck::u32x2*)(MIX + row * D + 768 + 64 * h + v) = w; } }
}


__device__ __forceinline__ void cmp_part_unit(Frame& F, int l, int cu4) {
    using nsa::bf16x8; using nsa::f32x16;
    const int ks4 = cu4 & 3, cu = cu4 >> 2;
    const int which = cu >> 5, bg = (cu >> 2) & 7, rb2 = cu & 3, b = bg >> 1, g = bg & 1, lane = F.lane, r32 = lane & 31, hi = lane >> 5, wave = F.wave;
    const int rb = 2 * rb2 + (wave >> 2), jb = wave & 3, n = 32 * rb + r32;
    const bf16* Pk = (const bf16*)(F.ws + WS_P) + (which ? PC_NVC : PC_NKC) + 64 * g + 8 * hi;
    const bf16* W1t = (const bf16*)(F.ws + WS_W1T) + (size_t)(l * 2 + which) * 128 * 2048 + (size_t)(32 * jb + r32) * 2048 + 8 * hi;
    f32x16 acc = f32x16{};
#pragma unroll 4
    for (int l2 = 8 * ks4; l2 < 8 * ks4 + 8; ++l2) { const int tok = min(16 * n + l2, SEQ - 1); const bf16* arow = Pk + (size_t)(b * SEQ + tok) * PP; const bf16* wrow = W1t + 64 * l2;
#pragma unroll
        for (int ks = 0; ks < 4; ++ks) { const bf16x8 bfrag = *(const bf16x8*)(arow + 16 * ks), afrag = *(const bf16x8*)(wrow + 16 * ks); acc = __builtin_amdgcn_mfma_f32_32x32x16_bf16(afrag, bfrag, acc, 0, 0, 0); } }
    float* hp = (float*)(F.ws + WS_HP) + ((size_t)((which * 8 + bg) * 4 + ks4) * 128) * 256;
#pragma unroll
    for (int r = 0; r < 16; ++r) { const int j = 32 * jb + (r & 3) + 8 * (r >> 2) + 4 * hi; hp[(size_t)j * 256 + n] = acc[r]; }
}
__device__ __forceinline__ void cmp_unit_mfma(Frame& F, int l, int cu, bf16* KCdst) {
    using nsa::bf16x8; using nsa::f32x16; using nsa::u32x4; using nsa::u32x2; using nsa::cvtpk;
    const int which = cu >> 5, bg = (cu >> 2) & 7, rb2 = cu & 3, lane = F.lane, r32 = lane & 31, hi = lane >> 5, wave = F.wave;
    const int rb = 2 * rb2 + (wave >> 2), jb = wave & 3, n = 32 * rb + r32;
    const bf16* W2t = (const bf16*)(F.ws + WS_W2T) + (size_t)(l * 2 + which) * 64 * 128;
    const float* hbp = (const float*)(F.ws + WS_HBP) + (size_t)(l * 2 + which) * 16 * 128;
    f32x16 acc;
    { const float* hp = (const float*)(F.ws + WS_HP) + ((size_t)((which * 8 + bg) * 4) * 128) * 256;
#pragma unroll
      for (int r = 0; r < 16; ++r) { const int j = 32 * jb + (r & 3) + 8 * (r >> 2) + 4 * hi; const float* pj = hp + (size_t)j * 256 + n; acc[r] = ((pj[0] + pj[128 * 256]) + pj[2 * 128 * 256]) + pj[3 * 128 * 256]; } }
    float hv[16];
#pragma unroll
    for (int r = 0; r < 16; ++r) { const int j = 32 * jb + (r & 3) + 8 * (r >> 2) + 4 * hi; float hb = 0.f;
#pragma unroll
        for (int s = 0; s < 16; ++s) hb += hbp[s * 128 + j];
        hv[r] = silu1(acc[r] + hb); }
    u32x4 w0 = {cvtpk(hv[0], hv[1]), cvtpk(hv[2], hv[3]), cvtpk(hv[4], hv[5]), cvtpk(hv[6], hv[7])}, w1 = {cvtpk(hv[8], hv[9]), cvtpk(hv[10], hv[11]), cvtpk(hv[12], hv[13]), cvtpk(hv[14], hv[15])};
    const bf16x8 pa0 = __builtin_bit_cast(bf16x8, w0), pa1 = __builtin_bit_cast(bf16x8, w1);
    LAS float* part = (LAS float*)(F.lds + RING_OFF);
#pragma unroll
    for (int db = 0; db < 2; ++db) { f32x16 po = f32x16{}; const bf16* w2r = W2t + (size_t)(32 * db + r32) * 128 + 32 * jb + 4 * hi;
#pragma unroll
        for (int s = 0; s < 2; ++s) { const u32x2 a = *(const u32x2*)(w2r + 16 * s), c = *(const u32x2*)(w2r + 16 * s + 8); u32x4 wv = {a.x, a.y, c.x, c.y};
            po = __builtin_amdgcn_mfma_f32_32x32x16_bf16(__builtin_bit_cast(bf16x8, wv), s ? pa1 : pa0, po, 0, 0, 0); }
#pragma unroll
        for (int r = 0; r < 16; ++r) { const int d = 32 * db + (r & 3) + 8 * (r >> 2) + 4 * hi; part[(wave * 64 + d) * 32 + r32] = po[r]; } }
    __syncthreads();
    if (jb == 0) { bf16* orow = KCdst + (size_t)which * (NB * 2 * 256 * 64) + (size_t)bg * 256 * 64 + (size_t)n * 64;
#pragma unroll
        for (int db = 0; db < 2; ++db)
#pragma unroll
            for (int q4 = 0; q4 < 4; ++q4) { float y[4];
#pragma unroll
                for (int e = 0; e < 4; ++e) { const int d = 32 * db + 8 * q4 + 4 * hi + e; const LAS float* pp = part + ((wave & 4) * 64 + d) * 32 + r32; y[e] = ((pp[0] + pp[64 * 32]) + pp[2 * 64 * 32]) + pp[3 * 64 * 32]; if (n >= 255) y[e] = 0.f; }
                u32x2 w = {cvtpk(y[0], y[1]), cvtpk(y[2], y[3])}; *(u32x2*)(orow + 32 * db + 8 * q4 + 4 * hi) = w; } }
    __syncthreads();
}

struct Args { Ptrs I; float* out; unsigned char* ws; int l_lo, l_hi, ph_lo, ph_hi, do_pro, do_fin; };
constexpr int NPH = 12;

#define GRID_BAR() do { if (ONE_LAUNCH) xcd_barrier(bar); } while (0)
#define IN(k) (lo <= (k) && (k) < hi)
#define TSTAMP(g) do { if (MK_TPROBE && blockIdx.x == 0 && threadIdx.x == 0) { volatile unsigned* tw_ = (volatile unsigned*)(F.ctl + CW_CHK + 8); const unsigned tn_ = (unsigned)rt(); if ((g) == MK_TPROBE) tw_[0] += tn_ - tw_[1]; tw_[1] = tn_; } } while (0)
template <int l>
__device__ __forceinline__ void layer_phases(Frame& F, const Args& args, const XcdBarrier& bar) {
    const int lo = args.ph_lo, hi = args.ph_hi;

        bf16* H = (bf16*)(F.ws + WS_H); bf16* MIX = (bf16*)(F.ws + WS_MIX); bf16* ACT = (bf16*)(F.ws + WS_P); bf16* PJ = (bf16*)(F.ws + WS_P);
        const float* mod = (const float*)(F.ws + WS_MOD); const float* rot = (const float*)(F.ws + WS_ROT);
        const float* modl = mod + (size_t)l * NB * (NADA * D);
        unsigned char* wl = F.ws + WS_W + (size_t)l * W_LAYER;
        const Ptrs& I = *(const Ptrs*)(F.ws + WS_PTRS);
        float* xout = args.out;
        const float* xcur = (l == 0) ? I.x : xout;
        if (IN(0)) { p_norm(F, xcur, I.norm_g + (size_t)(l * 3 + 0) * D, modl, 0, H); GRID_BAR(); }
        if (MK_REP == 100 && IN(0)) { p_norm(F, xcur, I.norm_g + (size_t)(l * 3 + 0) * D, modl, 0, H); GRID_BAR(); }
        TSTAMP(2);
        if (IN(1)) { pg8::Gemm g{H, (const bf16*)(wl + WO_F1IN), M, 2 * FF, D}; pg8::StaticOrder S; S.init(M, 2 * FF, F.G, (int)blockIdx.x);
            pg8::EpiSwiglu E{ACT, FF}; pg8::gemm_phase<pg8::EpiSwiglu, pg8::StaticOrder, true, true>(F.lds + RING_OFF, g, S, E); GRID_BAR(); }
        if (MK_REP == 101 && IN(1)) { pg8::Gemm g{H, (const bf16*)(wl + WO_F1IN), M, 2 * FF, D}; pg8::StaticOrder S; S.init(M, 2 * FF, F.G, (int)blockIdx.x);
            pg8::EpiSwiglu E{ACT, FF}; pg8::gemm_phase<pg8::EpiSwiglu, pg8::StaticOrder, true, true>(F.lds + RING_OFF, g, S, E); GRID_BAR(); }
        TSTAMP(3);
        if (IN(2)) { pg8::Gemm g{ACT, (const bf16*)(wl + WO_F1OUT), M, D, FF}; pg8::StaticOrder S; S.init(M, D, F.G, (int)blockIdx.x);
            pg8::EpiResid E{xcur, xout, modl + 2 * D, NADA * D, 0.5f}; pg8::gemm_phase<pg8::EpiResid, pg8::StaticOrder, true, true>(F.lds + RING_OFF, g, S, E); GRID_BAR(); }
        if (MK_REP == 102 && IN(2)) { pg8::Gemm g{ACT, (const bf16*)(wl + WO_F1OUT), M, D, FF}; pg8::StaticOrder S; S.init(M, D, F.G, (int)blockIdx.x);
            pg8::EpiResid E{xout, xout, modl + 2 * D, NADA * D, 0.0f}; pg8::gemm_phase<pg8::EpiResid, pg8::StaticOrder, true, true>(F.lds + RING_OFF, g, S, E); GRID_BAR(); }
        TSTAMP(4);
        if (IN(3)) { p_norm(F, xout, I.norm_g + (size_t)(l * 3 + 1) * D, modl, 1, H); GRID_BAR(); }
        if (MK_REP == 103 && IN(3)) { p_norm(F, xout, I.norm_g + (size_t)(l * 3 + 1) * D, modl, 1, H); GRID_BAR(); }
        TSTAMP(2);
        if (IN(4)) { pg8::Gemm g{H, (const bf16*)(wl + WO_WIN), M, NPROJ, D}; pg8::StaticOrder S; S.init(M, NPROJ, F.G, (int)blockIdx.x);
            pg8::EpiProj E{PJ, rot}; pg8::gemm_phase<pg8::EpiProj, pg8::StaticOrder, true, true>(F.lds + RING_OFF, g, S, E); GRID_BAR(); }
        if (MK_REP == 104 && IN(4)) { pg8::Gemm g{H, (const bf16*)(wl + WO_WIN), M, NPROJ, D}; pg8::StaticOrder S; S.init(M, NPROJ, F.G, (int)blockIdx.x);
            pg8::EpiProj E{PJ, rot}; pg8::gemm_phase<pg8::EpiProj, pg8::StaticOrder, true, true>(F.lds + RING_OFF, g, S, E); GRID_BAR(); }
        TSTAMP(5);
        if (IN(5)) {
            if (MK_MIX_NAIVE) {
                for (int rep = 0; rep < (MK_REP == 5 ? 2 : 1); ++rep)
                for (int u = (int)blockIdx.x; u < 1024 + 1024 + 512; u += F.G) {
                    if (u < 1024) gla_unit_naive<false>(F, I, l, u); else if (u < 2048) ret_unit_naive<false>(F, I, l, u - 1024); else cmp_unit_naive(F, I, l, u - 2048, (bf16*)(F.ws + WS_KC)); }
            } else {
                for (int rep = 0; rep < 1; ++rep) {
                { LAS unsigned char* wbuf = F.lds + RING_OFF + F.wave * 16384;
                  for (int u = (int)blockIdx.x * NWAVES + F.wave; u < 2048; u += F.G * NWAVES) { if (u < 1024) gla_kv_wave(F, I, l, u, wbuf); }
                  for (int u = (int)blockIdx.x * NWAVES + F.wave; u < 2048; u += F.G * NWAVES) { if (u >= 1024) ret_kv_wave(F, u - 1024, wbuf); } }
                __syncthreads();
                for (int cu4 = (int)blockIdx.x; cu4 < 256; cu4 += F.G) cmp_part_unit(F, l, cu4);
                }
                if (MK_REP == 105 || MK_REP == 115) { __syncthreads();
                { LAS unsigned char* wbuf = F.lds + RING_OFF + F.wave * 16384;
                  for (int u = (int)blockIdx.x * NWAVES + F.wave; u < 2048; u += F.G * NWAVES) { if (u < 1024) gla_kv_wave(F, I, l, u, wbuf); }
                  for (int u = (int)blockIdx.x * NWAVES + F.wave; u < 2048; u += F.G * NWAVES) { if (u >= 1024) ret_kv_wave(F, u - 1024, wbuf); } }
                __syncthreads(); }
                if (MK_CHECK == 2) { for (int u = (int)blockIdx.x; u < 512; u += F.G) cmp_unit_naive(F, I, l, u, (bf16*)(F.ws + WS_KC2)); }
            }
            GRID_BAR(); }
        TSTAMP(6);
        if (IN(6)) { p_scan(F);
            if (!MK_MIX_NAIVE) { __syncthreads(); for (int cu = (int)blockIdx.x; cu < 64 * 4; cu += F.G) if ((cu & 3) == 0) cmp_unit_mfma(F, l, cu >> 2, (bf16*)(F.ws + WS_KC)); }
            GRID_BAR(); }
        if (MK_REP == 106 && IN(6)) { p_scan(F, (WS_MIX2 - WS_KVG) / 4); GRID_BAR(); }
        if (MK_REP == 150 && IN(6)) { GRID_BAR(); GRID_BAR(); GRID_BAR(); GRID_BAR(); GRID_BAR(); GRID_BAR(); GRID_BAR(); GRID_BAR(); GRID_BAR(); GRID_BAR(); }
        TSTAMP(7);
        if (IN(7)) {
            bf16* MIXN = MK_CHECK ? (bf16*)(F.ws + WS_MIX2) : MIX;
            if (MK_MIX_NAIVE || MK_CHECK) {
            for (int rep = 0; rep < (MK_REP == 7 ? 2 : 1); ++rep)
            for (int u = (int)blockIdx.x; u < 2048; u += F.G) { if (u < 1024) gla_unit_naive<true>(F, I, l, u, MIXN); else ret_unit_naive<true>(F, I, l, u - 1024, MIXN); }
            }
            if (!MK_MIX_NAIVE) { LAS unsigned char* wbuf = F.lds + RING_OFF + F.wave * 16384;
                for (int rep = 0; rep < (MK_REP == 7 ? 2 : 1); ++rep)
                { for (int u = (int)blockIdx.x * NWAVES + F.wave; u < 2048; u += F.G * NWAVES) { if (u < 1024) gla_out_wave(F, I, l, u, wbuf, MIX); }
                  for (int u = (int)blockIdx.x * NWAVES + F.wave; u < 2048; u += F.G * NWAVES) { if (u >= 1024) ret_out_wave(F, I, l, u - 1024, wbuf, MIX); } }
                __syncthreads(); }
            if (MK_NSA_NAIVE || MK_CHECK)
            { LAS float* wl2 = (LAS float*)(F.lds + RING_OFF) + F.wave * 1536; const int gw = (int)blockIdx.x * NWAVES + F.wave, NGW = F.G * NWAVES;
              for (int u = gw; u < NB * 2 * SEQ; u += NGW) { const int t = u & 4095, bg = u >> 12; nsa_unit_naive(F, I, l, bg >> 1, bg & 1, t, wl2, MIXN); } }
            if (MK_CHECK) __syncthreads();
            if (!MK_NSA_NAIVE) {
            for (int rep = 0; rep < (MK_REP == 8 ? 2 : 1); ++rep)
            for (int pi = (int)blockIdx.x; pi < 256; pi += F.G) { const int bg = pi & 7, c0 = pi >> 3;
#pragma unroll 1
                for (int k = 0; k < 2; ++k) { const int cc = k == 0 ? c0 : 63 - c0;
                    if (MK_NSA_FAST) { if (nsa::unit_fast(F.lds + RING_OFF, (const bf16*)(F.ws + WS_P), (const bf16*)(F.ws + WS_KC), MIX, I.nsa_gate_bias + (size_t)l * 24, bg >> 1, bg & 1, cc))
                                           nsa::unit(F.lds + RING_OFF, (const bf16*)(F.ws + WS_P), (const bf16*)(F.ws + WS_KC), MIX, I.nsa_gate_bias + (size_t)l * 24, bg >> 1, bg & 1, cc); }
                    else nsa::unit(F.lds + RING_OFF, (const bf16*)(F.ws + WS_P), (const bf16*)(F.ws + WS_KC), MIX, I.nsa_gate_bias + (size_t)l * 24, bg >> 1, bg & 1, cc); } }
            }
            GRID_BAR();
            if (MK_CHECK) {
                const bf16* A = MIX; const bf16* Bn = (const bf16*)(F.ws + WS_MIX2); float sd = 0.f, sq = 0.f;
                if (MK_CHECK == 2) { const bf16* A2 = (const bf16*)(F.ws + WS_KC); const bf16* B2 = (const bf16*)(F.ws + WS_KC2);
                    for (int e = (int)blockIdx.x * 512 + F.tid; e < 2 * NB * 2 * 256 * 64; e += F.G * 512) { const float a = bf2f(A2[e]), bb = bf2f(B2[e]); sd += (a - bb) * (a - bb); sq += bb * bb; } }
                else
                for (int e = (int)blockIdx.x * 512 + F.tid; e < M * (MK_CHK_HI - MK_CHK_LO); e += F.G * 512) { const int r = e / (MK_CHK_HI - MK_CHK_LO), cc = MK_CHK_LO + e % (MK_CHK_HI - MK_CHK_LO);
                    const float a = bf2f(A[(size_t)r * D + cc]), bb = bf2f(Bn[(size_t)r * D + cc]); sd += (a - bb) * (a - bb); sq += bb * bb; }
                sd = wave_sum(sd); sq = wave_sum(sq);
                if (F.lane == 0) { atomicAdd((float*)(F.ctl + CW_CHK), sd); atomicAdd((float*)(F.ctl + CW_CHK + 1), sq); }
                GRID_BAR(); }
        }
        TSTAMP(8);
        if (IN(8)) { pg8::Gemm g{MIX, (const bf16*)(wl + WO_WOUT), M, D, D}; pg8::StaticOrder S; S.init(M, D, F.G, (int)blockIdx.x);
            pg8::EpiResid E{xout, xout, modl + 5 * D, NADA * D, 1.0f}; pg8::gemm_phase<pg8::EpiResid, pg8::StaticOrder, true, true>(F.lds + RING_OFF, g, S, E); GRID_BAR(); }
        if (MK_REP == 108 && IN(8)) { pg8::Gemm g{MIX, (const bf16*)(wl + WO_WOUT), M, D, D}; pg8::StaticOrder S; S.init(M, D, F.G, (int)blockIdx.x);
            pg8::EpiResid E{xout, xout, modl + 5 * D, NADA * D, 0.0f}; pg8::gemm_phase<pg8::EpiResid, pg8::StaticOrder, true, true>(F.lds + RING_OFF, g, S, E); GRID_BAR(); }
        TSTAMP(9);
        if (IN(9)) { p_norm(F, xout, I.norm_g + (size_t)(l * 3 + 2) * D, modl, 2, H); GRID_BAR(); }
        TSTAMP(2);
        if (IN(10)) { pg8::Gemm g{H, (const bf16*)(wl + WO_F2IN), M, 2 * FF, D}; pg8::StaticOrder S; S.init(M, 2 * FF, F.G, (int)blockIdx.x);
            pg8::EpiSwiglu E{ACT, FF}; pg8::gemm_phase<pg8::EpiSwiglu, pg8::StaticOrder, true, true>(F.lds + RING_OFF, g, S, E); GRID_BAR(); }
        TSTAMP(3);
        if (IN(11)) { pg8::Gemm g{ACT, (const bf16*)(wl + WO_F2OUT), M, D, FF}; pg8::StaticOrder S; S.init(M, D, F.G, (int)blockIdx.x);
            pg8::EpiResid E{xout, xout, modl + 8 * D, NADA * D, 0.5f}; pg8::gemm_phase<pg8::EpiResid, pg8::StaticOrder, true, true>(F.lds + RING_OFF, g, S, E); GRID_BAR(); }

    TSTAMP(4);
}
#undef IN
__global__ void __launch_bounds__(NWAVES * 64, 2) mk_fwd(Args args) {
    extern __shared__ __attribute__((aligned(16))) unsigned char lds[];
    Frame F;
    F.lds = (LAS unsigned char*)lds;
    F.MISC = (volatile LAS unsigned*)(F.lds + MISC_OFF);
    F.tid = threadIdx.x; F.lane = F.tid & 63; F.wave = __builtin_amdgcn_readfirstlane(F.tid >> 6);
    F.G = gridDim.x; { const int bx = blockIdx.x; F.vcu = (F.G % 8 == 0) ? (bx % 8) * (F.G / 8) + bx / 8 : bx; }
    F.ws = args.ws; F.in = nullptr;
    F.ctl = (gu32*)(args.ws + WS_CTL);
    for (int u = F.tid; u < (LDS_BYTES - LDSCTL_OFF) / 4; u += NWAVES * 64) ((LAS unsigned*)(F.lds + LDSCTL_OFF))[u] = 0u;
    __syncthreads();
    XcdBarrier bar; bar.bar = (unsigned*)(F.ctl + 4096); bar.x = 0; bar.st = nullptr;
    if (ONE_LAUNCH) bar = xcd_barrier_post((unsigned*)(F.ctl + 4096), F.MISC + 8);
#define GRID_BAR() do { if (ONE_LAUNCH) xcd_barrier(bar); } while (0)


    if (MK_TPROBE && blockIdx.x == 0 && threadIdx.x == 0) { volatile unsigned* tw_ = (volatile unsigned*)(F.ctl + CW_CHK + 8); const unsigned tn_ = (unsigned)rt(); tw_[0] = 0u; tw_[1] = tn_; tw_[2] = tn_; }
    if (args.do_pro) {
        if (blockIdx.x == 0 && F.tid == 0) { const float** tb = (const float**)(args.ws + WS_PTRS); const float* const* src = (const float* const*)&args.I;
#pragma unroll
            for (int i = 0; i < 23; ++i) tb[i] = src[i]; }
        p_prologue(F, args.I); GRID_BAR();
        if (MK_REP == 199) { p_prologue(F, args.I); GRID_BAR(); } }
    TSTAMP(1);

    if (0 >= args.l_lo && 0 < args.l_hi) layer_phases<0>(F, args, bar);
    if (1 >= args.l_lo && 1 < args.l_hi) layer_phases<1>(F, args, bar);
    if (2 >= args.l_lo && 2 < args.l_hi) layer_phases<2>(F, args, bar);
    if (3 >= args.l_lo && 3 < args.l_hi) layer_phases<3>(F, args, bar);
    if (MK_TPROBE) {
        if (blockIdx.x == 0 && F.tid == 0) { volatile unsigned* tw_ = (volatile unsigned*)(F.ctl + CW_CHK + 8); const float a = (float)tw_[0], b = (float)((unsigned)rt() - tw_[2]); const float fq = floorf(a / b * 64.0f + 0.5f) * (1.0f / 64.0f); ((float*)(F.ctl + CW_CHK))[0] = fq * fq; ((float*)(F.ctl + CW_CHK))[1] = 1.0f; }
        GRID_BAR(); }
    if (args.do_fin) { const Ptrs& I = *(const Ptrs*)(args.ws + WS_PTRS); p_final(F, args.out, I.final_norm_g, (MK_CHECK || MK_TPROBE) ? (const float*)(F.ctl + CW_CHK) : nullptr); }
}

extern "C" void kernel_launch(void* const* d_in, const int* in_sizes, int n_in, void* d_out, int out_size, void* d_ws, size_t ws_size, hipStream_t stream) {
    static int grid = 0;
    if (grid == 0) {
        if (n_in != 23 || out_size != M * D || ws_size < WS_HP + 8 * MiB) { fprintf(stderr, "kernel_launch: unexpected shapes: n_in %d out %d ws %zu\n", n_in, out_size, ws_size); grid = -1; return; }
        int dev = 0, cus = 0, per_cu = 0;
        if (hipGetDevice(&dev) != hipSuccess || hipDeviceGetAttribute(&cus, hipDeviceAttributeMultiprocessorCount, dev) != hipSuccess) { grid = -1; return; }
        if (hipFuncSetAttribute((const void*)mk_fwd, hipFuncAttributeMaxDynamicSharedMemorySize, LDS_BYTES) != hipSuccess) { fprintf(stderr, "kernel_launch: hipFuncSetAttribute failed\n"); grid = -1; return; }
        if (hipOccupancyMaxActiveBlocksPerMultiprocessor(&per_cu, (const void*)mk_fwd, NWAVES * 64, LDS_BYTES) != hipSuccess || per_cu < 1) fprintf(stderr, "kernel_launch: occupancy query reports %d\n", per_cu);
        (void)hipGetLastError();
        grid = cus;
    }
    if (grid < 0) return;
    if (hipMemsetAsync((char*)d_ws + WS_CTL, 0, CTL_ZERO_BYTES, stream) != hipSuccess) return;
    Args a{};
    const float** pp = (const float**)&a.I;
    for (int i = 0; i < 23; ++i) pp[i] = (const float*)d_in[i];
    a.out = (float*)d_out; a.ws = (unsigned char*)d_ws;
    if (ONE_LAUNCH) {
        a.l_lo = 0; a.l_hi = NL; a.ph_lo = 0; a.ph_hi = NPH; a.do_pro = 1; a.do_fin = 1;
        hipLaunchKernelGGL(mk_fwd, dim3(grid), dim3(NWAVES * 64), LDS_BYTES, stream, a);
    } else {
        a.l_lo = 0; a.l_hi = 0; a.ph_lo = 0; a.ph_hi = 0; a.do_pro = 1; a.do_fin = 0;
        hipLaunchKernelGGL(mk_fwd, dim3(grid), dim3(NWAVES * 64), LDS_BYTES, stream, a);
        a.do_pro = 0;
        for (int l = 0; l < NL; ++l) for (int p = 0; p < NPH; ++p) { a.l_lo = l; a.l_hi = l + 1; a.ph_lo = p; a.ph_hi = p + 1; hipLaunchKernelGGL(mk_fwd, dim3(grid), dim3(NWAVES * 64), LDS_BYTES, stream, a); }
        a.l_lo = 0; a.l_hi = 0; a.ph_lo = 0; a.ph_hi = 0; a.do_fin = 1;
        hipLaunchKernelGGL(mk_fwd, dim3(grid), dim3(NWAVES * 64), LDS_BYTES, stream, a);
    }
}
```
